# Optimizing an MI355X kernel written in HIP

```python
import jax, jax.numpy as jnp
from jax import lax
import numpy as np

D_MODEL = 1024
BATCH = 32
SEQ = 2048
DEPTH = 2

CHUNK = 64
EPS = 1e-6
NEG_INF = -1e30

CONV_WIDTH = D_MODEL // 2
CONV_KERNEL = 31
HEAD_DIM = 64
ATTN_HEADS = D_MODEL // 128
ATTN_WIDTH = ATTN_HEADS * HEAD_DIM
LEFT_CHUNKS = 8
BAND = (LEFT_CHUNKS + 1) * CHUNK
KEY_PAD = BAND - CHUNK
MAX_REL = 256
POOL_WINDOWS = (2, 4, 8, 16)
POOL_GROUPS = len(POOL_WINDOWS)
POOL_WIDTH = D_MODEL // 2
POOL_GROUP_DIM = POOL_WIDTH // POOL_GROUPS
N_BRANCH = 3

IN_SPLITS = (CONV_WIDTH, CONV_WIDTH, CONV_WIDTH,
             ATTN_WIDTH, ATTN_WIDTH, ATTN_WIDTH, ATTN_WIDTH,
             POOL_WIDTH, POOL_WIDTH,
             N_BRANCH * D_MODEL)
IN_COLS = sum(IN_SPLITS)

kernel_name = "hybrid_conv_chunkattn_pool_gated_block"


def rms_norm(x, g):
    xf = x.astype(jnp.float32)
    y = xf * lax.rsqrt(jnp.mean(xf * xf, axis=-1, keepdims=True) + EPS)
    return (y * g.astype(jnp.float32)).astype(x.dtype)


def layer_norm(x, g, b):
    xf = x.astype(jnp.float32)
    mu = jnp.mean(xf, axis=-1, keepdims=True)
    xc = xf - mu
    y = xc * lax.rsqrt(jnp.mean(xc * xc, axis=-1, keepdims=True) + EPS)
    return (y * g.astype(jnp.float32) + b.astype(jnp.float32)).astype(x.dtype)


def conv_branch(a, b, gate, dw, dw_b, ln_g, ln_b, w_o):
    u = a * jax.nn.sigmoid(b)
    u = lax.conv_general_dilated(
        u, dw[:, None, :], window_strides=(1,),
        padding=[(CONV_KERNEL - 1, 0)],
        dimension_numbers=('NWC', 'WIO', 'NWC'),
        feature_group_count=CONV_WIDTH) + dw_b
    u = jax.nn.silu(layer_norm(u, ln_g, ln_b))
    return (u * jax.nn.silu(gate)) @ w_o


def chunk_attention_branch(q, k, v, gate, rel_table, w_o):
    B, S, _ = q.shape
    n_chunks = S // CHUNK
    qc = (q * (HEAD_DIM ** -0.5)).reshape(B, n_chunks, CHUNK, ATTN_HEADS, HEAD_DIM)
    qc = qc.transpose(1, 0, 3, 2, 4)
    kh = k.reshape(B, S, ATTN_HEADS, HEAD_DIM).transpose(0, 2, 1, 3)
    vh = v.reshape(B, S, ATTN_HEADS, HEAD_DIM).transpose(0, 2, 1, 3)
    kh = jnp.pad(kh, ((0, 0), (0, 0), (KEY_PAD, 0), (0, 0)))
    vh = jnp.pad(vh, ((0, 0), (0, 0), (KEY_PAD, 0), (0, 0)))
    rel = jnp.arange(CHUNK)[:, None] + KEY_PAD - jnp.arange(BAND)[None, :]
    bias = rel_table[:, jnp.clip(rel, -MAX_REL, MAX_REL) + MAX_REL].astype(jnp.float32)
    key_offsets = jnp.arange(BAND) - KEY_PAD

    def one_chunk(args):
        q_blk, c = args
        start = c * CHUNK
        kb = lax.dynamic_slice_in_dim(kh, start, BAND, axis=2)
        vb = lax.dynamic_slice_in_dim(vh, start, BAND, axis=2)
        s = jnp.einsum('bhqd,bhkd->bhqk', q_blk, kb).astype(jnp.float32) + bias
        valid = (start + key_offsets) >= 0
        s = jnp.where(valid, s, NEG_INF)
        p = jax.nn.softmax(s, axis=-1).astype(vb.dtype)
        return jnp.einsum('bhqk,bhkd->bhqd', p, vb)

    o = lax.map(one_chunk, (qc, jnp.arange(n_chunks)))
    o = o.transpose(1, 0, 3, 2, 4).reshape(B, S, ATTN_WIDTH)
    return (o * jax.nn.silu(gate)) @ w_o


def pool_branch(u, gate, w_grp, b_grp, scale, w_o):
    B, S, _ = u.shape
    uf = u.astype(jnp.float32)
    cs = jnp.pad(jnp.cumsum(uf, axis=1), ((0, 0), (1, 0), (0, 0)))
    t = jnp.arange(S)
    outs = []
    for g, w in enumerate(POOL_WINDOWS):
        sl = slice(g * POOL_GROUP_DIM, (g + 1) * POOL_GROUP_DIM)
        csg = cs[..., sl]
        lower = jnp.concatenate(
            [jnp.zeros((B, w - 1, POOL_GROUP_DIM), jnp.float32), csg[:, :S + 1 - w]], axis=1)
        cnt = jnp.minimum(t + 1, w).astype(jnp.float32)[None, :, None]
        outs.append((csg[:, 1:] - lower) / cnt - uf[..., sl])
    pooled = jnp.stack(outs, axis=2).astype(u.dtype)
    mixed = jnp.einsum('bsgc,gcd->bsgd', pooled, w_grp) + b_grp
    mixed = mixed.reshape(B, S, POOL_WIDTH) * scale
    return (mixed * jax.nn.silu(gate)) @ w_o


def hybrid_layer(x, pre_g, post_g, w_in, conv_dw, conv_dw_b, conv_ln_g, conv_ln_b,
                 w_conv_out, rel_bias, w_attn_out, pool_w, pool_b, pool_scale,
                 w_pool_out, w_out):
    B, S, D = x.shape
    h = rms_norm(x, pre_g)
    z = h @ w_in
    (c_a, c_b, c_gate, q, k, v, a_gate, p_in, p_gate, g_merge) = jnp.split(
        z, np.cumsum(IN_SPLITS)[:-1].tolist(), axis=-1)
    y_conv = conv_branch(c_a, c_b, c_gate, conv_dw, conv_dw_b, conv_ln_g, conv_ln_b, w_conv_out)
    y_attn = chunk_attention_branch(q, k, v, a_gate, rel_bias, w_attn_out)
    y_pool = pool_branch(p_in, p_gate, pool_w, pool_b, pool_scale, w_pool_out)
    gates = jax.nn.sigmoid(g_merge).reshape(B, S, N_BRANCH, D)
    merged = gates[:, :, 0] * y_conv + gates[:, :, 1] * y_attn + gates[:, :, 2] * y_pool
    y = merged @ w_out
    return x + rms_norm(y, post_g)


def setup_inputs(seed: int = 0) -> dict:
    key = jax.random.key(seed)
    ks = jax.random.split(key, 20)
    n = lambda k, shape, s: jax.random.normal(k, shape, jnp.float32) * s
    L, D = DEPTH, D_MODEL
    return {
        "x": n(ks[0], (BATCH, SEQ, D), 1.0),
        "pre_norm_g": 1.0 + n(ks[1], (L, D), 0.05),
        "post_norm_g": 1.0 + n(ks[2], (L, D), 0.05),
        "w_in": n(ks[3], (L, D, IN_COLS), D ** -0.5),
        "conv_dw": n(ks[4], (L, CONV_KERNEL, CONV_WIDTH), CONV_KERNEL ** -0.5),
        "conv_dw_b": n(ks[5], (L, CONV_WIDTH), 0.02),
        "conv_ln_g": 1.0 + n(ks[6], (L, CONV_WIDTH), 0.05),
        "conv_ln_b": n(ks[7], (L, CONV_WIDTH), 0.02),
        "w_conv_out": n(ks[8], (L, CONV_WIDTH, D), CONV_WIDTH ** -0.5),
        "rel_bias": n(ks[9], (L, ATTN_HEADS, 2 * MAX_REL + 1), 0.1),
        "w_attn_out": n(ks[10], (L, ATTN_WIDTH, D), ATTN_WIDTH ** -0.5),
        "pool_w": n(ks[11], (L, POOL_GROUPS, POOL_GROUP_DIM, POOL_GROUP_DIM), POOL_GROUP_DIM ** -0.5),
        "pool_b": n(ks[12], (L, POOL_GROUPS, POOL_GROUP_DIM), 0.02),
        "pool_scale": 1.0 + n(ks[13], (L, POOL_WIDTH), 0.1),
        "w_pool_out": n(ks[14], (L, POOL_WIDTH, D), POOL_WIDTH ** -0.5),
        "w_out": n(ks[15], (L, D, D), D ** -0.5),
    }


def reference(x, pre_norm_g, post_norm_g, w_in, conv_dw, conv_dw_b, conv_ln_g, conv_ln_b,
              w_conv_out, rel_bias, w_attn_out, pool_w, pool_b, pool_scale, w_pool_out, w_out):
    for l in range(DEPTH):
        x = hybrid_layer(x, pre_norm_g[l], post_norm_g[l], w_in[l], conv_dw[l], conv_dw_b[l],
                         conv_ln_g[l], conv_ln_b[l], w_conv_out[l], rel_bias[l], w_attn_out[l],
                         pool_w[l], pool_b[l], pool_scale[l], w_pool_out[l], w_out[l])
    return x
```

```cpp
#include <hip/hip_runtime.h>
#include <hip/hip_cooperative_groups.h>
#include <cstdio>
#include <cstdint>
namespace cg = cooperative_groups;

#ifndef ONE_LAUNCH
#define ONE_LAUNCH 1
#endif

#define LAS __attribute__((address_space(3)))
typedef unsigned short bf16_t;
typedef short bf16x8 __attribute__((ext_vector_type(8)));
typedef float f32x4 __attribute__((ext_vector_type(4)));
typedef float f32x16 __attribute__((ext_vector_type(16)));
typedef unsigned u32x4 __attribute__((ext_vector_type(4)));
typedef unsigned u32x2 __attribute__((ext_vector_type(2)));

constexpr int D = 1024, SEQ = 2048, BATCH = 32, NTOK = BATCH * SEQ, DEPTH = 2;
constexpr int NBC = 32, MC = NBC * SEQ, NCH = BATCH / NBC;
constexpr int NIN = 7680;
constexpr int COL_CG = 0, COL_AG = 512, COL_PG = 1024, COL_U = 1536, COL_P = 2048, COL_GM = 0  , ZLD = 2624;
constexpr size_t HMSEG = (size_t)65536 * 512;
constexpr float EPS = 1e-6f;
constexpr int LDS_STAGE = 131072, LDS_BYTES = LDS_STAGE + 16;

constexpr size_t WS_WIN = 0;
constexpr size_t WS_WBR = WS_WIN + (size_t)2 * NIN * D * 2;
constexpr size_t WS_WOUT = WS_WBR + (size_t)2 * 3072 * 512 * 2;
constexpr size_t WS_WPOOL = WS_WOUT + (size_t)2 * D * D * 2;
constexpr size_t WS_XB = WS_WPOOL + (size_t)2 * 4 * 128 * 128 * 2;
constexpr size_t WS_RINV = WS_XB + (size_t)NTOK * D * 2;
constexpr size_t WS_Z = WS_RINV + (size_t)NTOK * 4;
constexpr size_t WS_HM = WS_Z + (size_t)MC * ZLD * 2;
constexpr size_t WS_MG = WS_HM;
constexpr size_t WS_Y = WS_HM + 2 * HMSEG * 2;
constexpr size_t WS_PART = WS_HM + 4 * HMSEG * 2;
constexpr int NIN1 = 4608, MAXG = 256;
constexpr size_t WS_WGY = WS_PART + (size_t)MC * 16 * 4;
constexpr size_t WS_GS = WS_WGY + (size_t)2 * 9216 * 512 * 2;
constexpr size_t WS_BAR = WS_GS + (size_t)MAXG * 65536 * 2;
constexpr size_t WS_BAR_BYTES = 16384;
constexpr size_t WS_END = WS_BAR + WS_BAR_BYTES;

struct Params {
    const float* in[16];
    float* out;
    unsigned char* ws;
    int mode;
    int pad;
};

typedef const Params __attribute__((address_space(4))) CP;
__device__ __forceinline__ CP* opaque_params() { CP* q = (CP*)__builtin_amdgcn_kernarg_segment_ptr(); asm volatile("" : "+s"(q)); return q; }
__device__ __forceinline__ int opaque_tid() { int t = threadIdx.x; asm volatile("" : "+v"(t)); return t; }
typedef __bf16 bf16v2_t __attribute__((ext_vector_type(2)));
__device__ __forceinline__ unsigned pk2(float lo, float hi) { bf16v2_t v; v[0] = (__bf16)lo; v[1] = (__bf16)hi; return __builtin_bit_cast(unsigned, v); }
__device__ __forceinline__ float bflo(unsigned u) { return __uint_as_float(u << 16); }
__device__ __forceinline__ float bfhi(unsigned u) { return __uint_as_float(u & 0xffff0000u); }
__device__ __forceinline__ float bf2f(bf16_t b) { return __uint_as_float(((unsigned)b) << 16); }
__device__ __forceinline__ float sigmoidf_(float x) { return __builtin_amdgcn_rcpf(1.f + __expf(-x)); }
__device__ __forceinline__ float wave_sum(float v) {
#pragma unroll
    for (int o = 1; o < 64; o <<= 1) v += __shfl_xor(v, o);
    return v;
}

#define XB_TMO      128
#define XB_XCNT(j)  (256  + 64 * (j))
#define XB_XSUB(j)  (1280 + 64 * (j))
#define XB_XGEN(j)  (2304 + 64 * (j))
#define XB_TOP      3328
#define XB_TOPGEN   3392
#define XCD_BAR_WORDS 3456
#define XB_SPIN_CAP (1u << 18)
__device__ __forceinline__ unsigned xb_ld(unsigned* p)              { return __hip_atomic_load(p, __ATOMIC_RELAXED, __HIP_MEMORY_SCOPE_AGENT); }
__device__ __forceinline__ unsigned xb_add(unsigned* p, unsigned v) { return __hip_atomic_fetch_add(p, v, __ATOMIC_RELAXED, __HIP_MEMORY_SCOPE_AGENT); }
__device__ __forceinline__ unsigned xb_xcc_id() { return (unsigned)__builtin_amdgcn_s_getreg((3 << 11) | 20) & 0xFu; }
#define XB_SPIN(cond, bar) do { unsigned _sp = 0; while (cond) { __builtin_amdgcn_s_sleep(1); \
    if ((++_sp & 255u) == 0u) { if (xb_ld(&(bar)[XB_TMO])) break; if (_sp > XB_SPIN_CAP) { atomicAdd(&(bar)[XB_TMO], 1u); break; } } } } while (0)
struct XcdBarrier { unsigned* bar; unsigned x; volatile LAS unsigned* st; };
__device__ __forceinline__ XcdBarrier xcd_barrier_post(unsigned* bar, volatile LAS unsigned* st) {
    XcdBarrier b; b.bar = bar; b.x = xb_xcc_id(); b.st = st;
    if (threadIdx.x == 0) (void)xb_add(&bar[XB_XCNT(b.x)], 1u);
    return b;
}
__device__ __forceinline__ void xcd_barrier_complete(unsigned* bar, unsigned x, unsigned& nloc, unsigned& nx) {
    const unsigned G = gridDim.x * gridDim.y * gridDim.z;
    unsigned sum, cnt, mine, sp = 0u;
    for (;;) {
        sum = 0u; cnt = 0u; mine = 0u;
#pragma unroll
        for (unsigned j = 0; j < 16; ++j) { const unsigned c = xb_ld(&bar[XB_XCNT(j)]); sum += c; cnt += (c > 0u) ? 1u : 0u; mine = (j == x) ? c : mine; }
        if (sum == G) break;
        __builtin_amdgcn_s_sleep(1);
        if ((++sp & 255u) == 0u) { if (xb_ld(&bar[XB_TMO])) break; if (sp > XB_SPIN_CAP) { atomicAdd(&bar[XB_TMO], 1u); break; } }
    }
    nloc = mine > 0u ? mine : 1u; nx = cnt > 0u ? cnt : 1u;
}
__device__ __forceinline__ void xcd_barrier(const XcdBarrier& b) {
    asm volatile("s_waitcnt vmcnt(0)" ::: "memory");
    __syncthreads();
    if (threadIdx.x == 0) {
        unsigned* bar = b.bar;
        __builtin_amdgcn_s_waitcnt(0);
        unsigned nloc = b.st[0], nx = b.st[1];
        if (nloc == 0u) { xcd_barrier_complete(bar, b.x, nloc, nx); b.st[0] = nloc; b.st[1] = nx; }
        const unsigned old = xb_add(&bar[XB_XSUB(b.x)], 1u);
        const unsigned gen = old / nloc;
        if (old + 1u == (gen + 1u) * nloc) {
            __builtin_amdgcn_fence(__ATOMIC_RELEASE, "agent");
            asm volatile("s_waitcnt vmcnt(0)" ::: "memory");
            const unsigned og = xb_add(&bar[XB_TOP], 1u);
            const unsigned tg = og / nx;
            if (og + 1u == (tg + 1u) * nx) xb_add(&bar[XB_TOPGEN], 1u);
            else XB_SPIN(xb_ld(&bar[XB_TOPGEN]) == tg, bar);
            __builtin_amdgcn_fence(__ATOMIC_ACQUIRE, "agent");
            xb_add(&bar[XB_XGEN(b.x)], 1u);
            asm volatile("s_waitcnt vmcnt(0)" ::: "memory");
        } else {
            XB_SPIN(xb_ld(&bar[XB_XGEN(b.x)]) == gen, bar);
            __builtin_amdgcn_fence(__ATOMIC_ACQUIRE, "agent");
            asm volatile("s_waitcnt vmcnt(0)" ::: "memory");
        }
    }
    __syncthreads();
}

namespace pg8 {
constexpr int BM = 256, BK = 64, HALF = 128, HTB = HALF * BK * 2, STAGE_BYTES = 8 * HTB, NXCD = 8, WGM = 8;
__host__ __device__ __forceinline__ int lds_byte(int r, int c) { const int st = (r >> 4) * 2 + (c >> 5), rr = r & 15, cc = c & 31, ob = rr * 64 + cc * 2; return st * 1024 + (ob ^ (((ob >> 9) & 1) << 5)); }
__host__ __device__ __forceinline__ void stage_rc(int b, int& R, int& C) { const int st = b / 1024, sb = b % 1024, swz = sb ^ (((sb >> 9) & 1) << 5); R = (st >> 1) * 16 + swz / 64; C = (st & 1) * 32 + (swz % 64) / 2; }
__host__ __device__ __forceinline__ int perm32(int rho) { const int n = rho >> 4, i = rho & 15; return 8 * (i >> 2) + 4 * n + (i & 3); }

struct Unit { int pm, pn, aux, kind; size_t aoff, boff; };
struct Gemm { const bf16_t* A; const bf16_t* Bt; int lda, K; };

struct TileOrder {
    int nM, nN, nwg;
    __device__ void init(int M, int N) { nM = M / BM; nN = N / BM; nwg = nM * nN; }
    __device__ bool tile(long L, int& pm, int& pn) const {
        if (L >= nwg) return false;
        int wgid = (int)L; { const int q = nwg / NXCD, r = nwg % NXCD, xcd = wgid % NXCD, off = wgid / NXCD; wgid = (xcd < r ? xcd * (q + 1) : r * (q + 1) + (xcd - r) * q) + off; }
        const int nig = WGM * nN, gid = wgid / nig, fm = gid * WGM, gsz = (nM - fm) < WGM ? (nM - fm) : WGM;
        pm = fm + ((wgid % nig) % gsz); pn = (wgid % nig) / gsz; return true;
    }
};
struct PlainSched {
    TileOrder T; int G, c; size_t astep, bstep;
    __device__ void init(int M, int N, int lda, int K, int G_, int c_) { T.init(M, N); G = G_; c = c_; astep = (size_t)BM * lda * 2; bstep = (size_t)BM * K * 2; }
    __device__ bool next(int i, Unit& u) const {
        if (!T.tile((long)i * G + c, u.pm, u.pn)) return false;
        u.aux = 0; u.aoff = (size_t)u.pm * astep; u.boff = (size_t)u.pn * bstep; return true;
    }
};
struct BranchSched {
    TileOrder T; int G, c; size_t astep, bstep;
    __device__ void init(int M, int G_, int c_) { T.init(M, D); G = G_; c = c_; astep = (size_t)BM * ZLD * 2; bstep = (size_t)BM * 512 * 2; }
    __device__ bool next(int i, Unit& u) const {
        const int j = i / 3, b = i - 3 * j;
        if (!T.tile((long)j * G + c, u.pm, u.pn)) return false;
        u.aux = b; u.aoff = (size_t)u.pm * astep + (size_t)b * 512 * 2; u.boff = (size_t)(b * 4 + u.pn) * bstep; return true;
    }
};

template <bool ALIGN_EPI, bool SP2, class Epi, class Sched>
__device__ __forceinline__ void gemm_phase(LAS unsigned char* lds, const Gemm g, const Sched& S, const Epi& E) {
    const int tid = opaque_tid(), wid = __builtin_amdgcn_readfirstlane(tid >> 6), lane = tid & 63, wr = wid >> 2, wc = wid & 3, fr = lane & 15, fq = lane >> 4;
    const int K = g.K, nt = K / BK, lda = g.lda;
    unsigned voffA[2], voffB[2];
#pragma unroll
    for (int i = 0; i < 2; ++i) { int R, C; stage_rc(tid * 16 + i * 8192, R, C); const int Rb = Epi::PERM ? ((R & ~31) + perm32(R & 31)) : R;
        voffA[i] = (unsigned)(R * lda + C) * 2u; voffB[i] = (unsigned)(Rb * K + C) * 2u; }
    const size_t kstep = (size_t)(BK * 2);
    const size_t hstepA = (size_t)HALF * lda * 2, hstepB = (size_t)HALF * K * 2;
    const unsigned ldsw = (unsigned)wid * 1024u;
    const int aoff = lds_byte(wr * 64 + fr, fq * 8), boff = lds_byte(wc * 32 + fr, fq * 8);
#define PG8_SA(b, h) (((b) * 2 + (h)) * HTB)
#define PG8_SB(b, h) ((4 + (b) * 2 + (h)) * HTB)
#define PG8_STAGE(bufoff, gbase, voff) do { _Pragma("unroll") for (int _i = 0; _i < 2; ++_i) \
        __builtin_amdgcn_global_load_lds((const unsigned*)((const char*)(gbase) + (voff)[_i]), (LAS unsigned*)(lds + (bufoff) + ldsw + _i * 8192), 16, 0, 0); } while (0)
#define PG8_LDA(dst, b, h) do { _Pragma("unroll") for (int m = 0; m < 4; ++m) _Pragma("unroll") for (int k = 0; k < 2; ++k) dst[m][k] = *(const LAS bf16x8*)(lds + PG8_SA(b, h) + aoff + m * 2048 + k * 1024); } while (0)
#define PG8_LDB(dst, b, h) do { _Pragma("unroll") for (int n = 0; n < 2; ++n) _Pragma("unroll") for (int k = 0; k < 2; ++k) dst[n][k] = *(const LAS bf16x8*)(lds + PG8_SB(b, h) + boff + n * 2048 + k * 1024); } while (0)
#define PG8_MMA(ai, bj, At, Bt) do { __builtin_amdgcn_s_setprio(1); _Pragma("unroll") for (int m = 0; m < 4; ++m) _Pragma("unroll") for (int n = 0; n < 2; ++n) _Pragma("unroll") for (int k = 0; k < 2; ++k) \
        acc[ai][bj][m][n] = __builtin_amdgcn_mfma_f32_16x16x32_bf16(Bt[n][k], At[m][k], acc[ai][bj][m][n], 0, 0, 0); __builtin_amdgcn_s_setprio(0); } while (0)
#define PG8_WAIT_V(n) asm volatile("s_waitcnt vmcnt(" #n ")" ::: "memory")
#define PG8_WAIT_L(n) asm volatile("s_waitcnt lgkmcnt(" #n ")" ::: "memory")
#define PG8_BAR __builtin_amdgcn_s_barrier()
#define PG8_SCHED __builtin_amdgcn_sched_barrier(0)
    Unit cur, nxt; int ui = 0;
    if (!S.next(0, cur)) return;
    f32x4 acc[2][2][4][2];
#pragma unroll
    for (int a = 0; a < 2; ++a)
#pragma unroll
        for (int b = 0; b < 2; ++b)
#pragma unroll
            for (int m = 0; m < 4; ++m)
#pragma unroll
                for (int n = 0; n < 2; ++n) acc[a][b][m][n] = (f32x4){0.f, 0.f, 0.f, 0.f};
    bf16x8 At[4][2], B0[2][2], B1[2][2];
    const char* cA = (const char*)g.A + cur.aoff; const char* cB = (const char*)g.Bt + cur.boff;
    typename Epi::Pre pre = E.prefetch(cur, wr, fr);
    if constexpr (SP2) {
        PG8_STAGE(PG8_SB(0, 0), cB, voffB); PG8_STAGE(PG8_SB(0, 1), cB + hstepB, voffB); PG8_STAGE(PG8_SA(0, 0), cA, voffA); PG8_STAGE(PG8_SA(0, 1), cA + hstepA, voffA);
        if (wr == 1) PG8_BAR;
        PG8_WAIT_V(2); PG8_BAR;
        PG8_STAGE(PG8_SB(1, 0), cB + kstep, voffB); PG8_STAGE(PG8_SA(1, 0), cA + kstep, voffA); PG8_STAGE(PG8_SB(1, 1), cB + hstepB + kstep, voffB);
        PG8_WAIT_V(6); PG8_BAR;
    } else {
        PG8_STAGE(PG8_SB(0, 0), cB, voffB); PG8_STAGE(PG8_SA(0, 0), cA, voffA); PG8_STAGE(PG8_SB(0, 1), cB + hstepB, voffB); PG8_STAGE(PG8_SA(0, 1), cA + hstepA, voffA);
        if (wr == 1) PG8_BAR;
        PG8_WAIT_V(4); PG8_BAR;
        PG8_STAGE(PG8_SB(1, 0), cB + kstep, voffB); PG8_STAGE(PG8_SA(1, 0), cA + kstep, voffA); PG8_STAGE(PG8_SB(1, 1), cB + hstepB + kstep, voffB);
        PG8_WAIT_V(6); PG8_BAR;
    }
    for (;;) {
        const bool has_next = S.next(ui + 1, nxt);
        const char* nA = has_next ? (const char*)g.A + nxt.aoff : cA; const char* nB = has_next ? (const char*)g.Bt + nxt.boff : cB;
        for (int t = 0; t < nt; t += 2) {
            const bool last = (t == nt - 2);
            const char* a1 = cA + (size_t)(t + 1) * kstep;
            const char* a2 = last ? nA : cA + (size_t)(t + 2) * kstep; const char* b2 = last ? nB : cB + (size_t)(t + 2) * kstep;
            const char* a3 = a2 + kstep; const char* b3 = b2 + kstep;
            if constexpr (SP2) {
            PG8_LDB(B0, 0, 0); PG8_LDB(B1, 0, 1); PG8_SCHED; PG8_LDA(At, 0, 0); PG8_STAGE(PG8_SA(1, 1), a1 + hstepA, voffA);
            PG8_WAIT_V(8); PG8_WAIT_L(0); PG8_BAR; PG8_MMA(0, 0, At, B0); PG8_MMA(0, 1, At, B1); PG8_BAR; PG8_SCHED;
            PG8_LDA(At, 0, 1); PG8_STAGE(PG8_SB(0, 0), b2, voffB); PG8_STAGE(PG8_SB(0, 1), b2 + hstepB, voffB); PG8_STAGE(PG8_SA(0, 0), a2, voffA);
            PG8_WAIT_V(8); PG8_WAIT_L(0); PG8_BAR; PG8_MMA(1, 0, At, B0); PG8_MMA(1, 1, At, B1); PG8_BAR; PG8_SCHED;
            PG8_LDB(B0, 1, 0); PG8_LDB(B1, 1, 1); PG8_SCHED; PG8_LDA(At, 1, 0); PG8_STAGE(PG8_SA(0, 1), a2 + hstepA, voffA);
            PG8_WAIT_V(8); PG8_WAIT_L(0); PG8_BAR; PG8_MMA(0, 0, At, B0); PG8_MMA(0, 1, At, B1); PG8_BAR; PG8_SCHED;
            PG8_LDA(At, 1, 1); PG8_STAGE(PG8_SB(1, 0), b3, voffB); PG8_STAGE(PG8_SB(1, 1), b3 + hstepB, voffB); PG8_STAGE(PG8_SA(1, 0), a3, voffA);
            PG8_WAIT_V(8); PG8_WAIT_L(0); PG8_BAR; PG8_MMA(1, 0, At, B0); PG8_MMA(1, 1, At, B1); PG8_BAR; PG8_SCHED;
            } else {
            PG8_LDB(B0, 0, 0); PG8_SCHED; PG8_LDA(At, 0, 0); PG8_STAGE(PG8_SA(1, 1), a1 + hstepA, voffA);
            PG8_WAIT_L(8); PG8_BAR; PG8_WAIT_L(0); PG8_MMA(0, 0, At, B0); PG8_BAR; PG8_SCHED;
            PG8_LDB(B1, 0, 1); PG8_STAGE(PG8_SB(0, 0), b2, voffB);
            PG8_BAR; PG8_WAIT_L(0); PG8_MMA(0, 1, At, B1); PG8_BAR;
            PG8_LDA(At, 0, 1); PG8_STAGE(PG8_SA(0, 0), a2, voffA);
            PG8_BAR; PG8_WAIT_L(0); PG8_MMA(1, 0, At, B0); PG8_BAR; PG8_SCHED;
            PG8_STAGE(PG8_SB(0, 1), b2 + hstepB, voffB);
            PG8_WAIT_V(6); PG8_BAR; PG8_MMA(1, 1, At, B1); PG8_BAR;
            PG8_LDB(B0, 1, 0); PG8_SCHED; PG8_LDA(At, 1, 0); PG8_STAGE(PG8_SA(0, 1), a2 + hstepA, voffA);
            PG8_WAIT_L(8); PG8_BAR; PG8_WAIT_L(0); PG8_MMA(0, 0, At, B0); PG8_BAR; PG8_SCHED;
            PG8_LDB(B1, 1, 1); PG8_STAGE(PG8_SB(1, 0), b3, voffB);
            PG8_BAR; PG8_WAIT_L(0); PG8_MMA(0, 1, At, B1); PG8_BAR;
            PG8_LDA(At, 1, 1); PG8_STAGE(PG8_SA(1, 0), a3, voffA);
            PG8_BAR; PG8_WAIT_L(0); PG8_MMA(1, 0, At, B0); PG8_BAR; PG8_SCHED;
            PG8_STAGE(PG8_SB(1, 1), b3 + hstepB, voffB);
            PG8_WAIT_V(6); PG8_BAR; PG8_MMA(1, 1, At, B1); PG8_BAR;
            }
        }
        if constexpr (ALIGN_EPI) { if (wr == 0) PG8_BAR; }
        E(acc, cur, wr, wc, fr, fq, pre);
        if (!has_next) break;
#pragma unroll
        for (int a = 0; a < 2; ++a)
#pragma unroll
            for (int b = 0; b < 2; ++b)
#pragma unroll
                for (int m = 0; m < 4; ++m)
#pragma unroll
                    for (int n = 0; n < 2; ++n) acc[a][b][m][n] = (f32x4){0.f, 0.f, 0.f, 0.f};
        cur = nxt; cA = nA; cB = nB; ++ui;
        pre = E.prefetch(cur, wr, fr);
        if constexpr (ALIGN_EPI) { if (wr == 1) PG8_BAR; }
    }
    PG8_WAIT_V(0);
    if constexpr (!ALIGN_EPI) { if (wr == 0) PG8_BAR; }
    PG8_BAR;
#undef PG8_SA
#undef PG8_SB
#undef PG8_STAGE
#undef PG8_LDA
#undef PG8_LDB
#undef PG8_MMA
#undef PG8_WAIT_V
#undef PG8_WAIT_L
#undef PG8_BAR
#undef PG8_SCHED
}

struct Epi1 {
    static constexpr bool PERM = true;
    bf16_t* Z; const float* rinv; bf16_t* HM;
    struct Pre { float rs[2][4]; };
    __device__ __forceinline__ Pre prefetch(const Unit& u, int wr, int fr) const {
        Pre p; const int row0 = u.pm * BM + wr * 64 + fr;
#pragma unroll
        for (int ai = 0; ai < 2; ++ai)
#pragma unroll
            for (int m = 0; m < 4; ++m) p.rs[ai][m] = rinv[row0 + ai * HALF + m * 16];
        return p;
    }
    __device__ __forceinline__ void operator()(const f32x4 (&acc)[2][2][4][2], const Unit& u, int wr, int wc, int fr, int fq, const Pre& pre) const {
        const int row0 = u.pm * BM + wr * 64 + fr; const int pn = u.pn;
        const float (&rsv)[2][4] = pre.rs;
        if (pn < 4) {
            const int col = COL_U + pn * 128 + wc * 32 + 8 * fq;
#pragma unroll
            for (int ai = 0; ai < 2; ++ai)
#pragma unroll
                for (int m = 0; m < 4; ++m) { const int row = row0 + ai * HALF + m * 16; const float rs = rsv[ai][m];
                    float o[8];
#pragma unroll
                    for (int n = 0; n < 2; ++n)
#pragma unroll
                        for (int j = 0; j < 4; ++j) o[4 * n + j] = acc[ai][0][m][n][j] * rs * sigmoidf_(acc[ai][1][m][n][j] * rs);
                    u32x4 v; v.x = pk2(o[0], o[1]); v.y = pk2(o[2], o[3]); v.z = pk2(o[4], o[5]); v.w = pk2(o[6], o[7]);
                    *(u32x4*)(Z + (size_t)row * ZLD + col) = v; }
        } else {
            int dcol, act;
            if (pn >= 6 && pn < 14) {
                const int seg = (pn - 6) >> 1, cseg = (pn & 1) * 256 + wc * 32 + 8 * fq, b = row0 >> 11, t0 = row0 & (SEQ - 1);
                bf16_t* hp = HM + (size_t)seg * HMSEG + ((size_t)(b * 8 + (cseg >> 6)) * SEQ + t0) * 64 + (cseg & 63);
                if (seg == 0) store_act<2, true>(acc, rsv, hp); else if (seg == 3) store_act<1, true>(acc, rsv, hp); else store_act<0, true>(acc, rsv, hp);
                return;
            }
            if (pn < 6) { dcol = COL_CG + (pn - 4) * 256; act = 1; }
            else if (pn < 16) { dcol = COL_P + (pn - 14) * 256; act = 0; }
            else if (pn < 18) { dcol = COL_PG + (pn - 16) * 256; act = 1; }
            else { dcol = COL_GM + (pn - 18) * 256; act = 3; }
            bf16_t* zp = Z + (size_t)row0 * ZLD + dcol + wc * 32 + 8 * fq;
            if (act == 0) store_act<0, false>(acc, rsv, zp); else if (act == 1) store_act<1, false>(acc, rsv, zp); else store_act<3, false>(acc, rsv, zp);
        }
    }
    template <int ACT, bool HEADM> static __device__ __forceinline__ void store_act(const f32x4 (&acc)[2][2][4][2], const float (&rsv)[2][4], bf16_t* zp) {
#pragma unroll
        for (int ai = 0; ai < 2; ++ai)
#pragma unroll
            for (int m = 0; m < 4; ++m) { const float rs = rsv[ai][m];
#pragma unroll
                for (int bj = 0; bj < 2; ++bj) { float o[8];
#pragma unroll
                    for (int n = 0; n < 2; ++n)
#pragma unroll
                        for (int j = 0; j < 4; ++j) { float z = acc[ai][bj][m][n][j] * rs;
                            if (ACT == 1) z = z * sigmoidf_(z); else if (ACT == 2) z = z * 0.18033688011112042f  ; else if (ACT == 3) z = sigmoidf_(z);
                            o[4 * n + j] = z; }
                    u32x4 v; v.x = pk2(o[0], o[1]); v.y = pk2(o[2], o[3]); v.z = pk2(o[4], o[5]); v.w = pk2(o[6], o[7]);
                    if (HEADM) *(u32x4*)(zp + (size_t)(ai * HALF + m * 16) * 64 + (size_t)bj * 2 * SEQ * 64) = v;
                    else *(u32x4*)(zp + (size_t)(ai * HALF + m * 16) * ZLD + bj * HALF) = v; } }
    }
};
struct Epi3 {
    static constexpr bool PERM = true;
    const bf16_t* Z; bf16_t* MG;
    struct Pre {};
    __device__ __forceinline__ Pre prefetch(const Unit&, int, int) const { return Pre{}; }
    __device__ __forceinline__ void operator()(const f32x4 (&acc)[2][2][4][2], const Unit& u, int wr, int wc, int fr, int fq, const Pre&) const {
        const int row0 = u.pm * BM + wr * 64 + fr; const int b = u.aux;
        const int col0 = u.pn * BM + wc * 32 + 8 * fq;
        const bf16_t* gbase = Z + (size_t)row0 * ZLD + COL_GM + b * D + col0;
        bf16_t* mbase = MG + (size_t)row0 * D + col0;
#pragma unroll
        for (int ai = 0; ai < 2; ++ai) {
            u32x4 gv[4][2], pv[4][2];
#pragma unroll
            for (int m = 0; m < 4; ++m)
#pragma unroll
                for (int bj = 0; bj < 2; ++bj) gv[m][bj] = *(const u32x4*)(gbase + (size_t)(ai * HALF + m * 16) * ZLD + bj * HALF);
            if (b > 0) {
#pragma unroll
                for (int m = 0; m < 4; ++m)
#pragma unroll
                    for (int bj = 0; bj < 2; ++bj) pv[m][bj] = *(const u32x4*)(mbase + (size_t)(ai * HALF + m * 16) * D + bj * HALF);
            } else {
#pragma unroll
                for (int m = 0; m < 4; ++m)
#pragma unroll
                    for (int bj = 0; bj < 2; ++bj) pv[m][bj] = (u32x4){0u, 0u, 0u, 0u};
            }
#pragma unroll
            for (int m = 0; m < 4; ++m)
#pragma unroll
                for (int bj = 0; bj < 2; ++bj) { const u32x4 g = gv[m][bj], q = pv[m][bj];
                    float o[8];
                    o[0] = acc[ai][bj][m][0][0] * bflo(g.x) + bflo(q.x); o[1] = acc[ai][bj][m][0][1] * bfhi(g.x) + bfhi(q.x); o[2] = acc[ai][bj][m][0][2] * bflo(g.y) + bflo(q.y); o[3] = acc[ai][bj][m][0][3] * bfhi(g.y) + bfhi(q.y);
                    o[4] = acc[ai][bj][m][1][0] * bflo(g.z) + bflo(q.z); o[5] = acc[ai][bj][m][1][1] * bfhi(g.z) + bfhi(q.z); o[6] = acc[ai][bj][m][1][2] * bflo(g.w) + bflo(q.w); o[7] = acc[ai][bj][m][1][3] * bfhi(g.w) + bfhi(q.w);
                    u32x4 v; v.x = pk2(o[0], o[1]); v.y = pk2(o[2], o[3]); v.z = pk2(o[4], o[5]); v.w = pk2(o[6], o[7]);
                    *(u32x4*)(mbase + (size_t)(ai * HALF + m * 16) * D + bj * HALF) = v; }
        }
    }
};
struct Epi4 {
    static constexpr bool PERM = true;
    bf16_t* Y; float* part;
    struct Pre {};
    __device__ __forceinline__ Pre prefetch(const Unit&, int, int) const { return Pre{}; }
    __device__ __forceinline__ void operator()(const f32x4 (&acc)[2][2][4][2], const Unit& u, int wr, int wc, int fr, int fq, const Pre&) const {
        const int row0 = u.pm * BM + wr * 64 + fr; const int col0 = u.pn * BM + wc * 32 + 8 * fq;
#pragma unroll
        for (int ai = 0; ai < 2; ++ai)
#pragma unroll
            for (int m = 0; m < 4; ++m) { const int row = row0 + ai * HALF + m * 16; float ss = 0.f;
#pragma unroll
                for (int bj = 0; bj < 2; ++bj) { const f32x4 a0 = acc[ai][bj][m][0], a1 = acc[ai][bj][m][1];
                    ss += a0[0] * a0[0] + a0[1] * a0[1] + a0[2] * a0[2] + a0[3] * a0[3] + a1[0] * a1[0] + a1[1] * a1[1] + a1[2] * a1[2] + a1[3] * a1[3];
                    u32x4 v; v.x = pk2(a0[0], a0[1]); v.y = pk2(a0[2], a0[3]); v.z = pk2(a1[0], a1[1]); v.w = pk2(a1[2], a1[3]);
                    *(u32x4*)(Y + (size_t)row * D + col0 + bj * HALF) = v; }
                ss += __shfl_xor(ss, 16); ss += __shfl_xor(ss, 32);
                if (fq == 0) part[(size_t)row * 16 + u.pn * 4 + wc] = ss; }
    }
};
struct Gemm2 { const bf16_t* A; const bf16_t* A2; const bf16_t* Bt; int lda, lda2, K; };
template <class Epi, class Sched>
__device__ __forceinline__ void gemm_phase_mix(LAS unsigned char* lds, const Gemm2 g, const Sched& S, const Epi& E) {
    const int tid = opaque_tid(), wid = __builtin_amdgcn_readfirstlane(tid >> 6), lane = tid & 63, wr = wid >> 2, wc = wid & 3, fr = lane & 15, fq = lane >> 4;
    const int K = g.K, nt = K / BK;
    unsigned voffA0, voffA20, voffB0;
    { int R, C; stage_rc(tid * 16, R, C); const int Rb = (R & ~31) + perm32(R & 31);
      voffA0 = (unsigned)(R * g.lda + C) * 2u; voffA20 = (unsigned)(R * g.lda2 + C) * 2u; voffB0 = (unsigned)(Rb * K + C) * 2u; }
    const unsigned p1A = 64u * g.lda * 2u, p1A2 = 64u * g.lda2 * 2u, p1B = 64u * K * 2u;
    const size_t kstep = (size_t)(BK * 2);
    const size_t hstepA = (size_t)HALF * g.lda * 2, hstepA2 = (size_t)HALF * g.lda2 * 2, hstepB = (size_t)HALF * K * 2;
    const unsigned ldsw = (unsigned)wid * 1024u;
    const int aoff = lds_byte(wr * 64 + fr, fq * 8), boff = lds_byte(wc * 32 + fr, fq * 8);
#define PG8_SA(b, h) (((b) * 2 + (h)) * HTB)
#define PG8_SB(b, h) ((4 + (b) * 2 + (h)) * HTB)
#define PG8_STAGE(bufoff, gbase, voff) do { _Pragma("unroll") for (int _i = 0; _i < 2; ++_i) \
        __builtin_amdgcn_global_load_lds((const unsigned*)((const char*)(gbase) + (size_t)_i * p1B + voffB0), (LAS unsigned*)(lds + (bufoff) + ldsw + _i * 8192), 16, 0, 0); } while (0)
#define PG8_STAGE_A(bufoff, gbase, k2) do { const unsigned _v = (k2) ? voffA20 : voffA0; const size_t _p = (k2) ? p1A2 : p1A; _Pragma("unroll") for (int _i = 0; _i < 2; ++_i) \
        __builtin_amdgcn_global_load_lds((const unsigned*)((const char*)(gbase) + (size_t)_i * _p + _v), (LAS unsigned*)(lds + (bufoff) + ldsw + _i * 8192), 16, 0, 0); } while (0)
#define PG8_LDA(dst, b, h) do { _Pragma("unroll") for (int m = 0; m < 4; ++m) _Pragma("unroll") for (int k = 0; k < 2; ++k) dst[m][k] = *(const LAS bf16x8*)(lds + PG8_SA(b, h) + aoff + m * 2048 + k * 1024); } while (0)
#define PG8_LDB(dst, b, h) do { _Pragma("unroll") for (int n = 0; n < 2; ++n) _Pragma("unroll") for (int k = 0; k < 2; ++k) dst[n][k] = *(const LAS bf16x8*)(lds + PG8_SB(b, h) + boff + n * 2048 + k * 1024); } while (0)
#define PG8_MMA(ai, bj, At, Bt) do { __builtin_amdgcn_s_setprio(1); _Pragma("unroll") for (int m = 0; m < 4; ++m) _Pragma("unroll") for (int n = 0; n < 2; ++n) _Pragma("unroll") for (int k = 0; k < 2; ++k) \
        acc[ai][bj][m][n] = __builtin_amdgcn_mfma_f32_16x16x32_bf16(Bt[n][k], At[m][k], acc[ai][bj][m][n], 0, 0, 0); __builtin_amdgcn_s_setprio(0); } while (0)
#define PG8_WAIT_V(n) asm volatile("s_waitcnt vmcnt(" #n ")" ::: "memory")
#define PG8_WAIT_L(n) asm volatile("s_waitcnt lgkmcnt(" #n ")" ::: "memory")
#define PG8_BAR __builtin_amdgcn_s_barrier()
#define PG8_SCHED __builtin_amdgcn_sched_barrier(0)
    Unit cur, nxt; int ui = 0;
    if (!S.next(0, cur)) return;
    f32x4 acc[2][2][4][2];
#pragma unroll
    for (int a = 0; a < 2; ++a)
#pragma unroll
        for (int b = 0; b < 2; ++b)
#pragma unroll
            for (int m = 0; m < 4; ++m)
#pragma unroll
                for (int n = 0; n < 2; ++n) acc[a][b][m][n] = (f32x4){0.f, 0.f, 0.f, 0.f};
    bf16x8 At[4][2], B0[2][2], B1[2][2];
    bool ck = cur.kind < 2;
    const char* cA = (ck ? (const char*)g.A2 : (const char*)g.A) + cur.aoff; const char* cB = (const char*)g.Bt + cur.boff;
    size_t chA = ck ? hstepA2 : hstepA;
    PG8_STAGE(PG8_SB(0, 0), cB, voffB); PG8_STAGE(PG8_SB(0, 1), cB + hstepB, voffB); PG8_STAGE_A(PG8_SA(0, 0), cA, ck); PG8_STAGE_A(PG8_SA(0, 1), cA + chA, ck);
    if (wr == 1) PG8_BAR;
    PG8_WAIT_V(2); PG8_BAR;
    PG8_STAGE(PG8_SB(1, 0), cB + kstep, voffB); PG8_STAGE_A(PG8_SA(1, 0), cA + kstep, ck); PG8_STAGE(PG8_SB(1, 1), cB + hstepB + kstep, voffB);
    PG8_WAIT_V(6); PG8_BAR;
    for (;;) {
        const bool has_next = S.next(ui + 1, nxt);
        const bool nk = has_next ? (nxt.kind < 2) : ck;
        const char* nA = has_next ? (nk ? (const char*)g.A2 : (const char*)g.A) + nxt.aoff : cA; const char* nB = has_next ? (const char*)g.Bt + nxt.boff : cB;
        const size_t nhA = nk ? hstepA2 : hstepA;
        for (int t = 0; t < nt; t += 2) {
            const bool last = (t == nt - 2);
            const char* a1 = cA + (size_t)(t + 1) * kstep;
            const char* a2 = last ? nA : cA + (size_t)(t + 2) * kstep; const char* b2 = last ? nB : cB + (size_t)(t + 2) * kstep;
            const bool k2 = last ? nk : ck; const size_t h2 = last ? nhA : chA;
            const char* a3 = a2 + kstep; const char* b3 = b2 + kstep;
            PG8_LDB(B0, 0, 0); PG8_LDB(B1, 0, 1); PG8_SCHED; PG8_LDA(At, 0, 0); PG8_STAGE_A(PG8_SA(1, 1), a1 + chA, ck);
            PG8_WAIT_V(8); PG8_WAIT_L(0); PG8_BAR; PG8_MMA(0, 0, At, B0); PG8_MMA(0, 1, At, B1); PG8_BAR; PG8_SCHED;
            PG8_LDA(At, 0, 1); PG8_STAGE(PG8_SB(0, 0), b2, voffB); PG8_STAGE(PG8_SB(0, 1), b2 + hstepB, voffB); PG8_STAGE_A(PG8_SA(0, 0), a2, k2);
            PG8_WAIT_V(8); PG8_WAIT_L(0); PG8_BAR; PG8_MMA(1, 0, At, B0); PG8_MMA(1, 1, At, B1); PG8_BAR; PG8_SCHED;
            PG8_LDB(B0, 1, 0); PG8_LDB(B1, 1, 1); PG8_SCHED; PG8_LDA(At, 1, 0); PG8_STAGE_A(PG8_SA(0, 1), a2 + h2, k2);
            PG8_WAIT_V(8); PG8_WAIT_L(0); PG8_BAR; PG8_MMA(0, 0, At, B0); PG8_MMA(0, 1, At, B1); PG8_BAR; PG8_SCHED;
            PG8_LDA(At, 1, 1); PG8_STAGE(PG8_SB(1, 0), b3, voffB); PG8_STAGE(PG8_SB(1, 1), b3 + hstepB, voffB); PG8_STAGE_A(PG8_SA(1, 0), a3, k2);
            PG8_WAIT_V(8); PG8_WAIT_L(0); PG8_BAR; PG8_MMA(1, 0, At, B0); PG8_MMA(1, 1, At, B1); PG8_BAR; PG8_SCHED;
        }
        const bool epi = (cur.kind != 0);
        if (epi) {
            if (wr == 0) PG8_BAR;
            E(acc, cur, wr, wc, fr, fq);
        }
        if (!has_next) break;
        if (epi) {
#pragma unroll
            for (int a = 0; a < 2; ++a)
#pragma unroll
                for (int b = 0; b < 2; ++b)
#pragma unroll
                    for (int m = 0; m < 4; ++m)
#pragma unroll
                        for (int n = 0; n < 2; ++n) acc[a][b][m][n] = (f32x4){0.f, 0.f, 0.f, 0.f};
        }
        cur = nxt; cA = nA; cB = nB; ck = nk; chA = nhA; ++ui;
        if (epi) { if (wr == 1) PG8_BAR; }
    }
    PG8_WAIT_V(0);
    PG8_BAR;
#undef PG8_SA
#undef PG8_SB
#undef PG8_STAGE
#undef PG8_STAGE_A
#undef PG8_LDA
#undef PG8_LDB
#undef PG8_MMA
#undef PG8_WAIT_V
#undef PG8_WAIT_L
#undef PG8_BAR
#undef PG8_SCHED
}
struct BranchSched2 {
    TileOrder T; int G, c;
    __device__ void init(int M, int G_, int c_) { T.init(M, D); G = G_; c = c_; }
    __device__ bool next(int i, Unit& u) const {
        const int j = i / 9, s = i - 9 * j, b = s / 3, w = s - 3 * b;
        if (!T.tile((long)j * G + c, u.pm, u.pn)) return false;
        u.aux = b; u.kind = w;
        if (w < 2) { u.aoff = (size_t)u.pm * BM * D * 2 + (size_t)w * 512 * 2; u.boff = (size_t)((b * 2 + w) * 1024 + u.pn * BM) * 512 * 2; }
        else { u.aoff = (size_t)u.pm * BM * ZLD * 2 + (size_t)b * 512 * 2; u.boff = (size_t)(6144 + b * 1024 + u.pn * BM) * 512 * 2; }
        return true;
    }
};
struct EpiGY {
    static constexpr bool PERM = true;
    bf16_t* S; const float* rinv; bf16_t* MG;
    __device__ __forceinline__ void operator()(const f32x4 (&acc)[2][2][4][2], const Unit& u, int wr, int wc, int fr, int fq) const {
        bf16_t* s0 = S; asm volatile("" : "+s"(s0));
        bf16_t* sp = s0 + (wr * 64 + fr) * 256 + wc * 32 + 8 * fq;
        if (u.kind == 1) {
            const int row0 = u.pm * BM + wr * 64 + fr;
            float rs[2][4];
#pragma unroll
            for (int ai = 0; ai < 2; ++ai)
#pragma unroll
                for (int m = 0; m < 4; ++m) rs[ai][m] = rinv[row0 + ai * HALF + m * 16];
#pragma unroll
            for (int ai = 0; ai < 2; ++ai)
#pragma unroll
                for (int m = 0; m < 4; ++m)
#pragma unroll
                    for (int bj = 0; bj < 2; ++bj) { float o[8];
#pragma unroll
                        for (int n = 0; n < 2; ++n)
#pragma unroll
                            for (int j = 0; j < 4; ++j) o[4 * n + j] = sigmoidf_(acc[ai][bj][m][n][j] * rs[ai][m]);
                        u32x4 v; v.x = pk2(o[0], o[1]); v.y = pk2(o[2], o[3]); v.z = pk2(o[4], o[5]); v.w = pk2(o[6], o[7]);
                        *(u32x4*)(sp + (ai * HALF + m * 16) * 256 + bj * HALF) = v; }
        } else {
            const int b = u.aux;
            bf16_t* mbase = MG + (size_t)(u.pm * BM + wr * 64 + fr) * D + u.pn * BM + wc * 32 + 8 * fq;
#pragma unroll
            for (int ai = 0; ai < 2; ++ai) {
                u32x4 gv[4][2], pv[4][2];
#pragma unroll
                for (int m = 0; m < 4; ++m)
#pragma unroll
                    for (int bj = 0; bj < 2; ++bj) gv[m][bj] = *(const u32x4*)(sp + (ai * HALF + m * 16) * 256 + bj * HALF);
                if (b > 0) {
#pragma unroll
                    for (int m = 0; m < 4; ++m)
#pragma unroll
                        for (int bj = 0; bj < 2; ++bj) pv[m][bj] = *(const u32x4*)(mbase + (size_t)(ai * HALF + m * 16) * D + bj * HALF);
                } else {
#pragma unroll
                    for (int m = 0; m < 4; ++m)
#pragma unroll
                        for (int bj = 0; bj < 2; ++bj) pv[m][bj] = (u32x4){0u, 0u, 0u, 0u};
                }
#pragma unroll
                for (int m = 0; m < 4; ++m)
#pragma unroll
                    for (int bj = 0; bj < 2; ++bj) { const u32x4 g = gv[m][bj], q = pv[m][bj];
                        float o[8];
                        o[0] = acc[ai][bj][m][0][0] * bflo(g.x) + bflo(q.x); o[1] = acc[ai][bj][m][0][1] * bfhi(g.x) + bfhi(q.x); o[2] = acc[ai][bj][m][0][2] * bflo(g.y) + bflo(q.y); o[3] = acc[ai][bj][m][0][3] * bfhi(g.y) + bfhi(q.y);
                        o[4] = acc[ai][bj][m][1][0] * bflo(g.z) + bflo(q.z); o[5] = acc[ai][bj][m][1][1] * bfhi(g.z) + bfhi(q.z); o[6] = acc[ai][bj][m][1][2] * bflo(g.w) + bflo(q.w); o[7] = acc[ai][bj][m][1][3] * bfhi(g.w) + bfhi(q.w);
                        u32x4 v; v.x = pk2(o[0], o[1]); v.y = pk2(o[2], o[3]); v.z = pk2(o[4], o[5]); v.w = pk2(o[6], o[7]);
                        *(u32x4*)(mbase + (size_t)(ai * HALF + m * 16) * D + bj * HALF) = v; }
            }
        }
    }
};
}

__device__ __forceinline__ void tr_wave(const float* src, int ld, int k0, int c0, bf16_t* dst, int ldd, int n0, int kd0, const float* gk, LAS float* scr, int lane) {
    const int cc = lane & 31, kh = lane >> 5;
#pragma unroll 8
    for (int i = 0; i < 32; ++i) { const int kk = 2 * i + kh; float v = src[(size_t)(k0 + kk) * ld + c0 + cc]; if (gk) v *= gk[k0 + kk]; scr[kk * 33 + cc] = v; }
    asm volatile("s_waitcnt lgkmcnt(0)" ::: "memory");
    const int c = lane & 7;
#pragma unroll
    for (int j = 0; j < 4; ++j) { const int n = (lane >> 3) + 8 * j; const LAS float* q = scr + (8 * c) * 33 + n;
        u32x4 o; o.x = pk2(q[0], q[33]); o.y = pk2(q[2 * 33], q[3 * 33]); o.z = pk2(q[4 * 33], q[5 * 33]); o.w = pk2(q[6 * 33], q[7 * 33]);
        *(u32x4*)(dst + (size_t)(n0 + n) * ldd + kd0 + 8 * c) = o; }
    asm volatile("s_waitcnt lgkmcnt(0)" ::: "memory");
}
__device__ __forceinline__ int win_srccol(int n) {
    if (n >= 1024) return n;
    const int pn = n >> 8, i = n & 255; return (i < 128) ? (128 * pn + i) : (512 + 128 * pn + (i - 128));
}
__device__ __forceinline__ void phase0(CP* pp, LAS unsigned char* lds) {
    const int tid = opaque_tid(), G = gridDim.x, bid = blockIdx.x;
    LAS float* scr = (LAS float*)lds;
    bf16_t* WinT = (bf16_t*)(pp->ws + WS_WIN); bf16_t* WGY = (bf16_t*)(pp->ws + WS_WGY); bf16_t* WoutT = (bf16_t*)(pp->ws + WS_WOUT); bf16_t* WpoolT = (bf16_t*)(pp->ws + WS_WPOOL);
    constexpr int I_IN = 16 * 240, I_BR = 8 * 32, I_OUT = 16 * 32, I_PW = 2 * 4, I_L = I_IN + 3 * I_BR + I_OUT + 4 * I_PW;
    { const int wv = __builtin_amdgcn_readfirstlane(tid >> 6), ln = tid & 63;
      LAS float* wscr = scr + wv * (64 * 33);
      for (int it = bid * 8 + wv; it < 2 * I_L; it += G * 8) {
        const int l = it / I_L; int r = it - l * I_L;
        if (r < I_IN) { const int kb = r / 240, nb = r % 240;
            if (nb * 32 < NIN1) tr_wave(pp->in[3] + (size_t)l * D * NIN, NIN, kb * 64, win_srccol(nb * 32), WinT + (size_t)l * NIN * D, D, nb * 32, kb * 64, pp->in[1] + l * D, wscr, ln);
            else { const int ng = nb * 32 - NIN1, b = ng >> 10, kh = kb >> 3;
                tr_wave(pp->in[3] + (size_t)l * D * NIN, NIN, kb * 64, nb * 32, WGY + ((size_t)l * 9216 + (b * 2 + kh) * 1024) * 512, 512, ng & 1023, (kb & 7) * 64, pp->in[1] + l * D, wscr, ln); }
            continue; }
        r -= I_IN;
        if (r < 3 * I_BR) { const int b = r / I_BR, q = r % I_BR, kb = q / 32, nb = q % 32; const float* src = pp->in[b == 0 ? 8 : (b == 1 ? 10 : 14)] + (size_t)l * 512 * D;
            tr_wave(src, D, kb * 64, nb * 32, WGY + ((size_t)l * 9216 + 6144 + b * 1024) * 512, 512, nb * 32, kb * 64, nullptr, wscr, ln); continue; }
        r -= 3 * I_BR;
        if (r < I_OUT) { const int kb = r / 32, nb = r % 32; tr_wave(pp->in[15] + (size_t)l * D * D, D, kb * 64, nb * 32, WoutT + (size_t)l * D * D, D, nb * 32, kb * 64, nullptr, wscr, ln); continue; }
        r -= I_OUT;
        { const int g = r >> 3, kb = (r >> 2) & 1, nb = r & 3; tr_wave(pp->in[11] + ((size_t)l * 4 + g) * 128 * 128, 128, kb * 64, nb * 32, WpoolT + ((size_t)l * 4 + g) * 128 * 128, 128, nb * 32, kb * 64, nullptr, wscr, ln); }
      }
    }
    const int wid = tid >> 6, lane = tid & 63;
    bf16_t* xb = (bf16_t*)(pp->ws + WS_XB); float* rinv = (float*)(pp->ws + WS_RINV);
    for (int row = bid * 8 + wid; row < NTOK; row += G * 8) {
        const f32x4* xr = (const f32x4*)(pp->in[0] + (size_t)row * D) + lane; float ss = 0.f;
        u32x2* o = (u32x2*)(xb + (size_t)row * D) + lane;
#pragma unroll
        for (int j = 0; j < 4; ++j) { const f32x4 v = xr[64 * j]; ss += v.x * v.x + v.y * v.y + v.z * v.z + v.w * v.w; u32x2 w; w.x = pk2(v.x, v.y); w.y = pk2(v.z, v.w); o[64 * j] = w; }
        ss = wave_sum(ss);
        if (lane == 0) rinv[row] = rsqrtf(ss * (1.f / D) + EPS);
    }
}

__device__ __forceinline__ void lds_barrier() { asm volatile("s_waitcnt lgkmcnt(0)" ::: "memory"); __builtin_amdgcn_s_barrier(); asm volatile("" ::: "memory"); }
__device__ __forceinline__ void conv_phase(CP* pp, int l, bf16_t* Z, LAS unsigned char* lds) {
    const int G = gridDim.x, bid = blockIdx.x;
    const int tid = opaque_tid(), wid = tid >> 6, lane = tid & 63;
    constexpr int NT = MC / 32;
    if (bid >= NT) return;
    LAS bf16_t* us = (LAS bf16_t*)lds;
    LAS float* vs = (LAS float*)(lds + 63488);
    typedef float f32x2 __attribute__((ext_vector_type(2)));
    const int cp = tid & 255, th = tid >> 8;
    const float* dw = pp->in[4] + (size_t)l * 31 * 512 + 2 * cp;
    f32x2 w[31];
#pragma unroll
    for (int j = 0; j < 31; ++j) w[j] = *(const f32x2*)(dw + j * 512);
    const f32x2 bias = *(const f32x2*)(pp->in[5] + l * 512 + 2 * cp);
    const float* lg = pp->in[6] + l * 512 + lane * 8; const float* lb = pp->in[7] + l * 512 + lane * 8;
#define CONV_LOAD(tile_, st_, gate_) do { const int bl_ = (tile_) >> 6, t0_ = ((tile_) & 63) * 32; const size_t rb_ = (size_t)bl_ * SEQ; \
        _Pragma("unroll") for (int k = 0; k < 8; ++k) { const int i = tid + 512 * k, rr = i >> 6, ch = i & 63, t = t0_ - 30 + rr; st_[k] = (u32x4){0u, 0u, 0u, 0u}; \
            if (i < 62 * 64 && t >= 0) st_[k] = *(const u32x4*)(Z + (rb_ + t) * ZLD + COL_U + ch * 8); } \
        _Pragma("unroll") for (int k = 0; k < 4; ++k) gate_[k] = *(const u32x4*)(Z + (rb_ + t0_ + wid * 4 + k) * ZLD + COL_CG + lane * 8); } while (0)
    u32x4 st[8], gate[4];
    int tile = bid;
    CONV_LOAD(tile, st, gate);
    for (;;) {
        const int bl = tile >> 6, t0 = (tile & 63) * 32; const size_t rowbase = (size_t)bl * SEQ;
#pragma unroll
        for (int k = 0; k < 8; ++k) { const int i = tid + 512 * k, rr = i >> 6, ch = i & 63;
            if (i < 62 * 64) *(LAS u32x4*)(us + rr * 512 + ch * 8) = st[k]; }
        lds_barrier();
        {
            const LAS unsigned* us32 = (const LAS unsigned*)us + (th * 16) * 256 + cp;
            f32x2 uw[46];
#pragma unroll
            for (int i = 0; i < 46; ++i) { const unsigned v = us32[i * 256]; uw[i].x = bflo(v); uw[i].y = bfhi(v); }
#pragma unroll
            for (int tt = 0; tt < 16; ++tt) { f32x2 a = bias;
#pragma unroll
                for (int j = 0; j < 31; ++j) a = __builtin_elementwise_fma(w[j], uw[tt + j], a);
                *(LAS f32x2*)(vs + (th * 16 + tt) * 512 + 2 * cp) = a; }
        }
        lds_barrier();
        const int ntile = tile + G; const bool more = ntile < NT;
        u32x4 gate_n[4];
#pragma unroll
        for (int k = 0; k < 4; ++k) gate_n[k] = (u32x4){0u, 0u, 0u, 0u};
        if (more) CONV_LOAD(ntile, st, gate_n);
        const f32x4 g0 = *(const f32x4*)lg, g1 = *(const f32x4*)(lg + 4), b0 = *(const f32x4*)lb, b1 = *(const f32x4*)(lb + 4);
#pragma unroll
        for (int k = 0; k < 4; ++k) { const int tt = wid * 4 + k;
            f32x4 x0 = *(const LAS f32x4*)(vs + tt * 512 + lane * 8), x1 = *(const LAS f32x4*)(vs + tt * 512 + lane * 8 + 4);
            const float mean = wave_sum((x0.x + x0.y) + (x0.z + x0.w) + (x1.x + x1.y) + (x1.z + x1.w)) * (1.f / 512);
            x0 = x0 - mean; x1 = x1 - mean;
            const float var = wave_sum(x0.x * x0.x + x0.y * x0.y + x0.z * x0.z + x0.w * x0.w + x1.x * x1.x + x1.y * x1.y + x1.z * x1.z + x1.w * x1.w) * (1.f / 512);
            const float rstd = rsqrtf(var + EPS);
            f32x4 y0 = x0 * rstd * g0 + b0, y1 = x1 * rstd * g1 + b1;
            bf16_t* gp = Z + (rowbase + t0 + tt) * ZLD + COL_CG + lane * 8;
            const u32x4 gv = gate[k];
            float o[8];
            o[0] = y0.x * sigmoidf_(y0.x) * bflo(gv.x); o[1] = y0.y * sigmoidf_(y0.y) * bfhi(gv.x); o[2] = y0.z * sigmoidf_(y0.z) * bflo(gv.y); o[3] = y0.w * sigmoidf_(y0.w) * bfhi(gv.y);
            o[4] = y1.x * sigmoidf_(y1.x) * bflo(gv.z); o[5] = y1.y * sigmoidf_(y1.y) * bfhi(gv.z); o[6] = y1.z * sigmoidf_(y1.z) * bflo(gv.w); o[7] = y1.w * sigmoidf_(y1.w) * bfhi(gv.w);
            u32x4 v; v.x = pk2(o[0], o[1]); v.y = pk2(o[2], o[3]); v.z = pk2(o[4], o[5]); v.w = pk2(o[6], o[7]);
            *(u32x4*)gp = v; }
        lds_barrier();
        if (!more) break;
        tile = ntile;
#pragma unroll
        for (int k = 0; k < 4; ++k) gate[k] = gate_n[k];
    }
#undef CONV_LOAD
}
template <int W> __device__ __forceinline__ void pool_window(LAS bf16_t* col, int base, int t0) {
    constexpr int PLD = 520;
    float v[47];
#pragma unroll
    for (int k = 16 - W; k < 47; ++k) v[k] = bf2f(col[(base + k) * PLD]);
    float s = 0.f;
#pragma unroll
    for (int k = 16 - W; k < 15; ++k) s += v[k];
    const float iw = 1.f / W;
#pragma unroll
    for (int j = 0; j < 32; ++j) {
        s += v[j + 15];
        const int t = t0 + base + j;
        const float ic = (t + 1 >= W) ? iw : __builtin_amdgcn_rcpf((float)(t + 1));
        const float pooled = s * ic - v[j + 15];
        s -= v[j + 16 - W];
        col[(base + j) * PLD] = (bf16_t)(pk2(pooled, 0.f) & 0xffffu);
    }
}
__device__ __forceinline__ void pool_tile(CP* pp, int l, bf16_t* Z, const bf16_t* WpoolT, int tile, LAS unsigned char* lds) {
    const int tid = opaque_tid(), wid = __builtin_amdgcn_readfirstlane(tid >> 6), lane = tid & 63, fr = lane & 15, fq = lane >> 4;
    const int bl = tile >> 5, t0 = (tile & 31) * 64; const size_t rowbase = (size_t)bl * SEQ;
    constexpr int PLD = 520;
    LAS bf16_t* pl = (LAS bf16_t*)lds;
    const int g = wid >> 1, ch0 = g * 128 + (wid & 1) * 64;
    bf16x8 bw[4][4];
#pragma unroll
    for (int nt = 0; nt < 4; ++nt)
#pragma unroll
        for (int kk = 0; kk < 4; ++kk) bw[nt][kk] = *(const bf16x8*)(WpoolT + ((size_t)ch0 + nt * 16 + fr) * 128 + kk * 32 + fq * 8);
    u32x2 gv[4][4];
#pragma unroll
    for (int rt = 0; rt < 4; ++rt)
#pragma unroll
        for (int nt = 0; nt < 4; ++nt) gv[rt][nt] = *(const u32x2*)(Z + (rowbase + t0 + rt * 16 + fr) * ZLD + COL_PG + ch0 + nt * 16 + fq * 4);
    {
        u32x4 st[10];
#pragma unroll
        for (int k = 0; k < 10; ++k) { const int i = tid + 512 * k, rr = i >> 6, ch = i & 63, t = t0 - 15 + rr; st[k] = (u32x4){0u, 0u, 0u, 0u};
            if (i < 79 * 64 && t >= 0) st[k] = *(const u32x4*)(Z + (rowbase + t) * ZLD + COL_P + ch * 8); }
#pragma unroll
        for (int k = 0; k < 10; ++k) { const int i = tid + 512 * k, rr = i >> 6, ch = i & 63;
            if (i < 79 * 64) *(LAS u32x4*)(pl + rr * PLD + ch * 8) = st[k]; }
    }
    lds_barrier();
    {
        LAS bf16_t* col = pl + tid;
        const int gg = wid >> 1;
        if (gg == 0) { pool_window<2>(col, 0, t0); pool_window<2>(col, 32, t0); }
        else if (gg == 1) { pool_window<4>(col, 0, t0); pool_window<4>(col, 32, t0); }
        else if (gg == 2) { pool_window<8>(col, 0, t0); pool_window<8>(col, 32, t0); }
        else { pool_window<16>(col, 0, t0); pool_window<16>(col, 32, t0); }
    }
    lds_barrier();
    {
        const float* pb = pp->in[12] + l * 512 + ch0 + fq * 4; const float* sc = pp->in[13] + l * 512 + ch0 + fq * 4;
        f32x4 bb[4], ss[4];
#pragma unroll
        for (int nt = 0; nt < 4; ++nt) { bb[nt] = *(const f32x4*)(pb + nt * 16); ss[nt] = *(const f32x4*)(sc + nt * 16); }
#pragma unroll
        for (int rt = 0; rt < 4; ++rt) {
            bf16x8 a[4];
#pragma unroll
            for (int kk = 0; kk < 4; ++kk) a[kk] = *(const LAS bf16x8*)(pl + (rt * 16 + fr) * PLD + g * 128 + kk * 32 + fq * 8);
#pragma unroll
            for (int nt = 0; nt < 4; ++nt) { f32x4 acc = (f32x4){0.f, 0.f, 0.f, 0.f};
#pragma unroll
                for (int kk = 0; kk < 4; ++kk) acc = __builtin_amdgcn_mfma_f32_16x16x32_bf16(bw[nt][kk], a[kk], acc, 0, 0, 0);
                const u32x2 q = gv[rt][nt];
                u32x2 v; v.x = pk2((acc[0] + bb[nt].x) * ss[nt].x * bflo(q.x), (acc[1] + bb[nt].y) * ss[nt].y * bfhi(q.x)); v.y = pk2((acc[2] + bb[nt].z) * ss[nt].z * bflo(q.y), (acc[3] + bb[nt].w) * ss[nt].w * bfhi(q.y));
                *(u32x2*)(Z + (rowbase + t0 + rt * 16 + fr) * ZLD + COL_PG + ch0 + nt * 16 + fq * 4) = v; }
        }
    }
    lds_barrier();
}
__device__ __forceinline__ float xhalf_max(float v) { const auto rr = __builtin_amdgcn_permlane32_swap(__float_as_uint(v), __float_as_uint(v), false, false); return fmaxf(__uint_as_float(rr[0]), __uint_as_float(rr[1])); }
__device__ __forceinline__ float xhalf_sum(float v) { const auto rr = __builtin_amdgcn_permlane32_swap(__float_as_uint(v), __float_as_uint(v), false, false); return __uint_as_float(rr[0]) + __uint_as_float(rr[1]); }
typedef short v4i16_t __attribute__((ext_vector_type(4)));
__device__ __forceinline__ v4i16_t tr_read(const LAS unsigned char* p) { return __builtin_amdgcn_ds_read_tr16_b64_v4i16((LAS v4i16_t*)p); }
constexpr int ATT_KS = 144, ATT_KB = 32 * ATT_KS, ATT_VH = 2112, ATT_TAB = 9216, ATT_WAVE = ATT_TAB + 2304;
__device__ __forceinline__ void attn_wave(CP* pp, int l, bf16_t* Z, int bl, int h, int c, int lane, LAS unsigned char* wl, bool load_tab) {
    const int r = lane & 31, hh = lane >> 5;
    const size_t rowbase = (size_t)bl * SEQ;
    const int q0 = c * 64;
    const bf16_t* HMb = (const bf16_t*)(pp->ws + WS_HM); const size_t hrow = (size_t)(bl * 8 + h) * SEQ;
    bf16x8 qf[2][4];
#pragma unroll
    for (int qt = 0; qt < 2; ++qt)
#pragma unroll
        for (int s = 0; s < 4; ++s) qf[qt][s] = *(const bf16x8*)(HMb + (hrow + q0 + qt * 32 + r) * 64 + 16 * s + 8 * hh);
    const float* tabg = pp->in[9] + ((size_t)l * 8 + h) * 513;
    constexpr float LOG2E = 1.4426950408889634f;
    const float c512 = tabg[512] * LOG2E;
    LAS float* tab = (LAS float*)(wl + ATT_TAB);
    if (load_tab) {
#pragma unroll
        for (int i = 0; i < 5; ++i) tab[192 + 64 * i + lane] = tabg[192 + 64 * i + lane] * LOG2E;
        if (lane == 0) tab[512] = c512;
    }
    float m_run[2] = {-1e30f, -1e30f}, l_run[2] = {0.f, 0.f};
    f32x16 o[2][2];
#pragma unroll
    for (int a = 0; a < 2; ++a)
#pragma unroll
        for (int b = 0; b < 2; ++b)
#pragma unroll
            for (int i = 0; i < 16; ++i) o[a][b][i] = 0.f;
    const int kstart = max(0, q0 - 512), kend = q0 + 64;
    const int skey = lane >> 3, sch = lane & 7;
    const bf16_t* kg = HMb + HMSEG + (hrow + skey) * 64 + sch * 8;
    const bf16_t* vg = HMb + 2 * HMSEG + (hrow + skey) * 64 + sch * 8;
    LAS unsigned char* kw = wl + skey * ATT_KS + sch * 16;
    LAS unsigned char* vw = wl + ATT_KB + (sch >> 2) * ATT_VH + skey * 64 + (sch & 3) * 16;
    const LAS unsigned char* kr = wl + r * ATT_KS + 16 * hh;
    const LAS unsigned char* vr = wl + ATT_KB + (4 * hh + ((lane & 15) >> 2)) * 64 + (16 * ((lane >> 4) & 1) + 4 * (lane & 3)) * 2;
    u32x4 pk_[4], pv_[4];
#pragma unroll
    for (int i = 0; i < 4; ++i) { pk_[i] = *(const u32x4*)(kg + (size_t)(kstart + 8 * i) * 64); pv_[i] = *(const u32x4*)(vg + (size_t)(kstart + 8 * i) * 64); }
#pragma unroll
    for (int i = 0; i < 4; ++i) { *(LAS u32x4*)(kw + i * 8 * ATT_KS) = pk_[i]; *(LAS u32x4*)(vw + i * 512) = pv_[i]; }
    for (int kt = kstart; kt < kend; kt += 32) {
        const bool more = kt + 32 < kend;
        if (more) {
#pragma unroll
            for (int i = 0; i < 4; ++i) { pk_[i] = *(const u32x4*)(kg + (size_t)(kt + 32 + 8 * i) * 64); pv_[i] = *(const u32x4*)(vg + (size_t)(kt + 32 + 8 * i) * 64); }
        }
        bf16x8 kf[4];
#pragma unroll
        for (int s4 = 0; s4 < 4; ++s4) kf[s4] = *(const LAS bf16x8*)(kr + 32 * s4);
        bf16x8 pb[2][2];
#pragma unroll
        for (int qt = 0; qt < 2; ++qt) {
            f32x16 s;
            const int dqk = q0 + qt * 32 - kt;
            if (dqk > 256) {
#pragma unroll
                for (int i = 0; i < 16; ++i) s[i] = c512;
            } else if (dqk == 256) {
                const int rel0 = dqk + r - 4 * hh;
#pragma unroll
                for (int i = 0; i < 16; ++i) { const int rel = rel0 - ((i & 3) + 8 * (i >> 2)); s[i] = tab[min(rel, 256) + 256]; }
            } else {
                const LAS float* tb = tab + (dqk + r - 4 * hh + 256 - 27);
#pragma unroll
                for (int i = 0; i < 16; ++i) s[i] = tb[27 - ((i & 3) + 8 * (i >> 2))];
            }
#pragma unroll
            for (int s4 = 0; s4 < 4; ++s4) s = __builtin_amdgcn_mfma_f32_32x32x16_bf16(kf[s4], qf[qt][s4], s, 0, 0, 0);
            float mx = s[0];
#pragma unroll
            for (int i = 1; i < 16; ++i) mx = fmaxf(mx, s[i]);
            mx = xhalf_max(mx);
            const float m_new = fmaxf(m_run[qt], mx);
            if (__builtin_amdgcn_ballot_w64(m_new > m_run[qt]) != 0ull) {
                const float alpha = __builtin_amdgcn_exp2f(m_run[qt] - m_new);
                l_run[qt] *= alpha; m_run[qt] = m_new;
#pragma unroll
                for (int i = 0; i < 16; ++i) { o[qt][0][i] *= alpha; o[qt][1][i] *= alpha; }
            }
            float pv[16];
#pragma unroll
            for (int i = 0; i < 16; ++i) pv[i] = __builtin_amdgcn_exp2f(s[i] - m_new);
            float ps = ((pv[0] + pv[1]) + (pv[2] + pv[3])) + ((pv[4] + pv[5]) + (pv[6] + pv[7])) + (((pv[8] + pv[9]) + (pv[10] + pv[11])) + ((pv[12] + pv[13]) + (pv[14] + pv[15])));
            ps = xhalf_sum(ps);
            l_run[qt] += ps;
#pragma unroll
            for (int s2 = 0; s2 < 2; ++s2) { u32x4 t; t.x = pk2(pv[8 * s2 + 0], pv[8 * s2 + 1]); t.y = pk2(pv[8 * s2 + 2], pv[8 * s2 + 3]); t.z = pk2(pv[8 * s2 + 4], pv[8 * s2 + 5]); t.w = pk2(pv[8 * s2 + 6], pv[8 * s2 + 7]);
                pb[qt][s2] = __builtin_bit_cast(bf16x8, t); }
        }
#pragma unroll
        for (int dt = 0; dt < 2; ++dt)
#pragma unroll
            for (int s2 = 0; s2 < 2; ++s2) {
                const v4i16_t lo = tr_read(vr + dt * ATT_VH + s2 * 1024), hi = tr_read(vr + dt * ATT_VH + s2 * 1024 + 512);
                const bf16x8 vf = __builtin_shufflevector(lo, hi, 0, 1, 2, 3, 4, 5, 6, 7);
                o[0][dt] = __builtin_amdgcn_mfma_f32_32x32x16_bf16(vf, pb[0][s2], o[0][dt], 0, 0, 0);
                o[1][dt] = __builtin_amdgcn_mfma_f32_32x32x16_bf16(vf, pb[1][s2], o[1][dt], 0, 0, 0);
            }
        if (more) {
#pragma unroll
            for (int i = 0; i < 4; ++i) { *(LAS u32x4*)(kw + i * 8 * ATT_KS) = pk_[i]; *(LAS u32x4*)(vw + i * 512) = pv_[i]; }
        }
    }
#pragma unroll
    for (int qt = 0; qt < 2; ++qt) {
        const float inv = __builtin_amdgcn_rcpf(l_run[qt]);
        bf16_t* gp = Z + (rowbase + q0 + qt * 32 + r) * ZLD + COL_AG + h * 64 + 4 * hh;
#pragma unroll
        for (int dt = 0; dt < 2; ++dt)
#pragma unroll
            for (int g4 = 0; g4 < 4; ++g4) { bf16_t* a = gp + dt * 32 + 8 * g4; const u32x2 gv = *(const u32x2*)(HMb + 3 * HMSEG + (hrow + q0 + qt * 32 + r) * 64 + 4 * hh + dt * 32 + 8 * g4);
                u32x2 v; v.x = pk2(o[qt][dt][4 * g4 + 0] * inv * bflo(gv.x), o[qt][dt][4 * g4 + 1] * inv * bfhi(gv.x)); v.y = pk2(o[qt][dt][4 * g4 + 2] * inv * bflo(gv.y), o[qt][dt][4 * g4 + 3] * inv * bfhi(gv.y));
                *(u32x2*)a = v; }
    }
}
__device__ __forceinline__ void phase2(CP* pp, int l, LAS unsigned char* lds, int parts = 7) {
    const int G = gridDim.x, bid = blockIdx.x, tid = opaque_tid(), wid = tid >> 6, lane = tid & 63;
    bf16_t* Z = (bf16_t*)(pp->ws + WS_Z);
    const bf16_t* WpoolT = (const bf16_t*)(pp->ws + WS_WPOOL) + (size_t)l * 4 * 128 * 128;
    if (parts & 1) {
        const int uw = __builtin_amdgcn_readfirstlane(wid);
        int round = 0, prev_h = -1;
        for (int it = bid; it < NBC * 8 * 4; it += G, ++round) {
            const int pair = it >> 2, q = ((it & 3) + round) & 3, bl = pair >> 3, h = pair & 7;
            const int sd = uw & 3, hf = uw >> 2;
            const int c = (sd == q) ? (hf ? 7 - q : q) : (8 + 6 * q + 2 * (sd < q ? sd : sd - 1) + hf);
            attn_wave(pp, l, Z, bl, h, c, lane, lds + uw * ATT_WAVE, h != prev_h);
            prev_h = h;
        }
        __syncthreads();
    }
    if (parts & 2) { conv_phase(pp, l, Z, lds); __syncthreads(); }
    if (parts & 4) { for (int t = bid; t < MC / 64; t += G) pool_tile(pp, l, Z, WpoolT, t, lds); __syncthreads(); }
}

__device__ __forceinline__ void phase5(CP* pp, int l, int chunk) {
    const int G = gridDim.x, bid = blockIdx.x, tid = opaque_tid(), wid = tid >> 6, lane = tid & 63;
    const bf16_t* Y = (const bf16_t*)(pp->ws + WS_Y); const float* part = (const float*)(pp->ws + WS_PART);
    bf16_t* xb = (bf16_t*)(pp->ws + WS_XB); float* rinv = (float*)(pp->ws + WS_RINV);
    const bool first = (l == 0), last = (l == DEPTH - 1);
    const f32x4* gp = (const f32x4*)(pp->in[2] + l * D) + lane;
    f32x4 g[4];
#pragma unroll
    for (int j = 0; j < 4; ++j) g[j] = gp[64 * j];
    for (int lr = bid * 8 + wid; lr < MC; lr += G * 8) {
        const size_t row = (size_t)chunk * MC + lr;
        float ss = (lane < 16) ? part[(size_t)lr * 16 + lane] : 0.f;
        const u32x2* yr = (const u32x2*)(Y + (size_t)lr * D) + lane; u32x2* xo = (u32x2*)(xb + row * D) + lane;
        f32x4 xv[4]; u32x2 yv[4];
        if (first) { const f32x4* xr = (const f32x4*)(pp->in[0] + row * D) + lane;
#pragma unroll
            for (int j = 0; j < 4; ++j) xv[j] = xr[64 * j];
        } else {
#pragma unroll
            for (int j = 0; j < 4; ++j) { const u32x2 v = xo[64 * j]; xv[j].x = bflo(v.x); xv[j].y = bfhi(v.x); xv[j].z = bflo(v.y); xv[j].w = bfhi(v.y); }
        }
#pragma unroll
        for (int j = 0; j < 4; ++j) yv[j] = yr[64 * j];
        ss = wave_sum(ss);
        const float ry = rsqrtf(ss * (1.f / D) + EPS);
        float s2 = 0.f;
#pragma unroll
        for (int j = 0; j < 4; ++j) { f32x4 o;
            o.x = xv[j].x + bflo(yv[j].x) * ry * g[j].x; o.y = xv[j].y + bfhi(yv[j].x) * ry * g[j].y; o.z = xv[j].z + bflo(yv[j].y) * ry * g[j].z; o.w = xv[j].w + bfhi(yv[j].y) * ry * g[j].w;
            if (last) { ((f32x4*)(pp->out + row * D) + lane)[64 * j] = o; }
            else { s2 += o.x * o.x + o.y * o.y + o.z * o.z + o.w * o.w; u32x2 w; w.x = pk2(o.x, o.y); w.y = pk2(o.z, o.w); xo[64 * j] = w; } }
        if (!last) { s2 = wave_sum(s2); if (lane == 0) rinv[row] = rsqrtf(s2 * (1.f / D) + EPS); }
    }
}

#ifndef GEMM_ALIGN
#define GEMM_ALIGN true
#endif
#ifndef GEMM_SP2
#define GEMM_SP2 true
#endif
#ifndef PROBE
#define PROBE 0
#endif
constexpr int R12 = (PROBE >= 1 && PROBE <= 4) ? 2 : 1, PROBE_PARTS = PROBE == 2 ? 1 : (PROBE == 3 ? 2 : (PROBE == 4 ? 4 : 0)), R3 = PROBE == 5 ? 2 : 1, R4 = PROBE == 6 ? 2 : 1, RSYNC = PROBE == 7 ? 8 : 0;
__global__ void __launch_bounds__(512, 2) mega(Params p_unused) {
    extern __shared__ __attribute__((aligned(16))) unsigned char smem[];
    LAS unsigned char* lds = (LAS unsigned char*)smem;
    const int mode = opaque_params()->mode;
    int ph = 0;
    if (mode == -2) cg::this_grid().sync();
    XcdBarrier xb;
    { volatile LAS unsigned* st = (volatile LAS unsigned*)(lds + LDS_STAGE);
      if (threadIdx.x == 0) { st[0] = 0u; st[1] = 0u; }
      __syncthreads();
      xb = xcd_barrier_post((unsigned*)(opaque_params()->ws + WS_BAR), st);
      if (mode >= 0) xb.x = 0; }
#define SEAM() do { if (mode < 0) { xcd_barrier(xb); } ++ph; } while (0)
#define RUN(ph_) (mode < 0 || mode == (ph_))
#ifndef SKIP_P0
    if (RUN(ph)) phase0(opaque_params(), lds);
#endif
    SEAM();
#define DO_P1(l_, ch_) do { CP* pp = opaque_params(); unsigned char* ws = pp->ws; const int G = gridDim.x, bid = blockIdx.x; \
        pg8::Gemm g{(const bf16_t*)(ws + WS_XB) + (size_t)(ch_) * MC * D, (const bf16_t*)(ws + WS_WIN) + (size_t)(l_) * NIN * D, D, D}; \
        pg8::PlainSched S; S.init(MC, NIN1, D, D, G, bid); \
        pg8::Epi1 E{(bf16_t*)(ws + WS_Z), (const float*)(ws + WS_RINV) + (size_t)(ch_) * MC, (bf16_t*)(ws + WS_HM)}; \
        pg8::gemm_phase<GEMM_ALIGN, GEMM_SP2>(lds, g, S, E); } while (0)
    constexpr int NP = DEPTH * NCH;
    int p1_l = 0, p1_ch = 0;
    bool p1_first = true;
    for (int k = 0; k <= NP; ++k) {
        const int l = k / NCH, ch = k - l * NCH;
        if (RUN(ph)) {
            if (k > 0) phase5(opaque_params(), (k - 1) / NCH, (k - 1) % NCH);
            if (NCH > 1 && k < NP) DO_P1(l, ch);
        }
        if (k == NP || (k == 0 && NCH == 1)) ++ph; else SEAM();
        if (k == NP) break;
        if (NCH == 1) { if (RUN(ph)) DO_P1(l, ch); SEAM(); }
        for (int rep = 1; rep < R12; ++rep) {
            if (RUN(ph)) phase2(opaque_params(), l, lds, PROBE_PARTS);
            SEAM();
            if (RUN(ph)) DO_P1(l, ch);
            SEAM();
        }
        if (RUN(ph)) phase2(opaque_params(), l, lds, 7);
        SEAM();
        for (int rep = 0; rep < R3; ++rep) {
            if (RUN(ph)) {
                CP* pp = opaque_params(); unsigned char* ws = pp->ws; const int G = gridDim.x, bid = blockIdx.x;
                pg8::Gemm2 g{(const bf16_t*)(ws + WS_Z), (const bf16_t*)(ws + WS_XB) + (size_t)ch * MC * D, (const bf16_t*)(ws + WS_WGY) + (size_t)l * 9216 * 512, ZLD, D, 512};
                pg8::BranchSched2 S; S.init(MC, G, bid);
                pg8::EpiGY E{(bf16_t*)(ws + WS_GS) + (size_t)bid * 65536, (const float*)(ws + WS_RINV) + (size_t)ch * MC, (bf16_t*)(ws + WS_MG)};
                pg8::gemm_phase_mix(lds, g, S, E);
            }
            SEAM();
        }
        for (int rep = 0; rep < R4; ++rep) {
            if (RUN(ph)) {
                CP* pp = opaque_params(); unsigned char* ws = pp->ws; const int G = gridDim.x, bid = blockIdx.x;
                pg8::Gemm g{(const bf16_t*)(ws + WS_MG), (const bf16_t*)(ws + WS_WOUT) + (size_t)l * D * D, D, D};
                pg8::PlainSched S; S.init(MC, D, D, D, G, bid);
                pg8::Epi4 E{(bf16_t*)(ws + WS_Y), (float*)(ws + WS_PART)};
                pg8::gemm_phase<GEMM_ALIGN, GEMM_SP2>(lds, g, S, E);
            }
            SEAM();
        }
        for (int rep = 0; rep < RSYNC; ++rep) SEAM();
    }
    (void)p1_l; (void)p1_ch; (void)p1_first;
#undef DO_P1
#undef SEAM
#undef RUN
}
constexpr int N_PHASES = 1 + (DEPTH * NCH + 1) + DEPTH * NCH * (2 * (R12 - 1) + 1 + R3 + R4 + RSYNC);

extern "C" void kernel_launch(void* const* d_in, const int* in_sizes, int n_in, void* d_out, int out_size, void* d_ws, size_t ws_size, hipStream_t stream) {
    static int grid = 0;
    if (grid == 0) {
        if (n_in != 16 || in_sizes[0] != NTOK * D || out_size != NTOK * D || ws_size < WS_END) {
            fprintf(stderr, "kernel_launch: unexpected shapes (n_in %d, in0 %d, out %d, ws %zu < %zu)\n", n_in, n_in > 0 ? in_sizes[0] : -1, out_size, ws_size, (size_t)WS_END); grid = -1; return; }
        int dev = 0, cus = 0, per_cu = 0;
        (void)hipGetDevice(&dev); (void)hipDeviceGetAttribute(&cus, hipDeviceAttributeMultiprocessorCount, dev);
        if (hipFuncSetAttribute((const void*)mega, hipFuncAttributeMaxDynamicSharedMemorySize, LDS_BYTES) != hipSuccess) { fprintf(stderr, "kernel_launch: hipFuncSetAttribute failed\n"); grid = -1; return; }
        if (hipOccupancyMaxActiveBlocksPerMultiprocessor(&per_cu, (const void*)mega, 512, LDS_BYTES) != hipSuccess || per_cu < 1) { fprintf(stderr, "kernel_launch: occupancy query says %d\n", per_cu); per_cu = 1; }
        (void)hipGetLastError();
        grid = cus * per_cu; if (grid > MAXG) grid = MAXG;
        fprintf(stderr, "kernel_launch: grid %d (%d CUs x %d)\n", grid, cus, per_cu);
    }
    if (grid < 0) return;
    Params p{};
    for (int i = 0; i < 16; ++i) p.in[i] = (const float*)d_in[i];
    p.out = (float*)d_out; p.ws = (unsigned char*)d_ws; p.pad = 0;
#if ONE_LAUNCH
    p.mode = -1;
    if (hipMemsetAsync((char*)d_ws + WS_BAR, 0, WS_BAR_BYTES, stream) != hipSuccess) { fprintf(stderr, "kernel_launch: memset of the barrier words failed\n"); return; }
    void* args[] = {&p};
    hipError_t e = hipLaunchCooperativeKernel((const void*)mega, dim3(grid), dim3(512), args, LDS_BYTES, stream);
    if (e != hipSuccess) fprintf(stderr, "cooperative launch failed: %s (grid %d)\n", hipGetErrorString(e), grid);
#else
    for (int ph = 0; ph < N_PHASES; ++ph) { p.mode = ph; hipLaunchKernelGGL(mega, dim3(grid), dim3(512), LDS_BYTES, stream, p); }
#endif
}
```

```cpp
#include <hip/hip_runtime.h>
#include <hip/hip_cooperative_groups.h>
#include <cstdio>
#include <cstdint>
namespace cg = cooperative_groups;

#ifndef ONE_LAUNCH
#define ONE_LAUNCH 1
#endif

#define LAS __attribute__((address_space(3)))
typedef unsigned short bf16_t;
typedef short bf16x8 __attribute__((ext_vector_type(8)));
typedef float f32x4 __attribute__((ext_vector_type(4)));
typedef float f32x16 __attribute__((ext_vector_type(16)));
typedef unsigned u32x4 __attribute__((ext_vector_type(4)));
typedef unsigned u32x2 __attribute__((ext_vector_type(2)));

constexpr int D = 1024, SEQ = 2048, BATCH = 32, NTOK = BATCH * SEQ, DEPTH = 2;
constexpr int NBC = 32, MC = NBC * SEQ, NCH = BATCH / NBC;
constexpr int NIN = 7680;
constexpr int COL_CG = 0, COL_AG = 512, COL_PG = 1024, COL_U = 1536, COL_P = 2048, COL_GM = 0  , ZLD = 2624;
constexpr size_t HMSEG = (size_t)65536 * 512;
constexpr float EPS = 1e-6f;
constexpr int LDS_STAGE = 131072, LDS_BYTES = LDS_STAGE + 16;

constexpr size_t WS_WIN = 0;
constexpr size_t WS_WBR = WS_WIN + (size_t)2 * NIN * D * 2;
constexpr size_t WS_WOUT = WS_WBR + (size_t)2 * 3072 * 512 * 2;
constexpr size_t WS_WPOOL = WS_WOUT + (size_t)2 * D * D * 2;
constexpr size_t WS_XB = WS_WPOOL + (size_t)2 * 4 * 128 * 128 * 2;
constexpr size_t WS_RINV = WS_XB + (size_t)NTOK * D * 2;
constexpr size_t WS_Z = WS_RINV + (size_t)NTOK * 4;
constexpr size_t WS_HM = WS_Z + (size_t)MC * ZLD * 2;
constexpr size_t WS_MG = WS_HM;
constexpr size_t WS_Y = WS_HM + 2 * HMSEG * 2;
constexpr size_t WS_PART = WS_HM + 4 * HMSEG * 2;
constexpr int NIN1 = 4608, MAXG = 256;
constexpr size_t WS_WGY = WS_PART + (size_t)MC * 16 * 4;
constexpr size_t WS_GS = WS_WGY + (size_t)2 * 9216 * 512 * 2;
constexpr size_t WS_BAR = WS_GS + (size_t)MAXG * 65536 * 2;
constexpr size_t WS_BAR_BYTES = 16384;
constexpr size_t WS_END = WS_BAR + WS_BAR_BYTES;

struct Params {
    const float* in[16];
    float* out;
    unsigned char* ws;
    int mode;
    int pad;
};

typedef const Params __attribute__((address_space(4))) CP;
__device__ __forceinline__ CP* opaque_params() { CP* q = (CP*)__builtin_amdgcn_kernarg_segment_ptr(); asm volatile("" : "+s"(q)); return q; }
__device__ __forceinline__ int opaque_tid() { int t = threadIdx.x; asm volatile("" : "+v"(t)); return t; }
typedef __bf16 bf16v2_t __attribute__((ext_vector_type(2)));
__device__ __forceinline__ unsigned pk2(float lo, float hi) { bf16v2_t v; v[0] = (__bf16)lo; v[1] = (__bf16)hi; return __builtin_bit_cast(unsigned, v); }
__device__ __forceinline__ float bflo(unsigned u) { return __uint_as_float(u << 16); }
__device__ __forceinline__ float bfhi(unsigned u) { return __uint_as_float(u & 0xffff0000u); }
__device__ __forceinline__ float bf2f(bf16_t b) { return __uint_as_float(((unsigned)b) << 16); }
__device__ __forceinline__ float sigmoidf_(float x) { return __builtin_amdgcn_rcpf(1.f + __expf(-x)); }
__device__ __forceinline__ float wave_sum(float v) {
#pragma unroll
    for (int o = 1; o < 64; o <<= 1) v += __shfl_xor(v, o);
    return v;
}

#define XB_TMO      128
#define XB_XCNT(j)  (256  + 64 * (j))
#define XB_XSUB(j)  (1280 + 64 * (j))
#define XB_XGEN(j)  (2304 + 64 * (j))
#define XB_TOP      3328
#define XB_TOPGEN   3392
#define XCD_BAR_WORDS 3456
#define XB_SPIN_CAP (1u << 18)
__device__ __forceinline__ unsigned xb_ld(unsigned* p)              { return __hip_atomic_load(p, __ATOMIC_RELAXED, __HIP_MEMORY_SCOPE_AGENT); }
__device__ __forceinline__ unsigned xb_add(unsigned* p, unsigned v) { return __hip_atomic_fetch_add(p, v, __ATOMIC_RELAXED, __HIP_MEMORY_SCOPE_AGENT); }
__device__ __forceinline__ unsigned xb_xcc_id() { return (unsigned)__builtin_amdgcn_s_getreg((3 << 11) | 20) & 0xFu; }
#define XB_SPIN(cond, bar) do { unsigned _sp = 0; while (cond) { __builtin_amdgcn_s_sleep(1); \
    if ((++_sp & 255u) == 0u) { if (xb_ld(&(bar)[XB_TMO])) break; if (_sp > XB_SPIN_CAP) { atomicAdd(&(bar)[XB_TMO], 1u); break; } } } } while (0)
struct XcdBarrier { unsigned* bar; unsigned x; volatile LAS unsigned* st; };
__device__ __forceinline__ XcdBarrier xcd_barrier_post(unsigned* bar, volatile LAS unsigned* st) {
    XcdBarrier b; b.bar = bar; b.x = xb_xcc_id(); b.st = st;
    if (threadIdx.x == 0) (void)xb_add(&bar[XB_XCNT(b.x)], 1u);
    return b;
}
__device__ __forceinline__ void xcd_barrier_complete(unsigned* bar, unsigned x, unsigned& nloc, unsigned& nx) {
    const unsigned G = gridDim.x * gridDim.y * gridDim.z;
    unsigned sum, cnt, mine, sp = 0u;
    for (;;) {
        sum = 0u; cnt = 0u; mine = 0u;
#pragma unroll
        for (unsigned j = 0; j < 16; ++j) { const unsigned c = xb_ld(&bar[XB_XCNT(j)]); sum += c; cnt += (c > 0u) ? 1u : 0u; mine = (j == x) ? c : mine; }
        if (sum == G) break;
        __builtin_amdgcn_s_sleep(1);
        if ((++sp & 255u) == 0u) { if (xb_ld(&bar[XB_TMO])) break; if (sp > XB_SPIN_CAP) { atomicAdd(&bar[XB_TMO], 1u); break; } }
    }
    nloc = mine > 0u ? mine : 1u; nx = cnt > 0u ? cnt : 1u;
}
__device__ __forceinline__ void xcd_barrier(const XcdBarrier& b) {
    asm volatile("s_waitcnt vmcnt(0)" ::: "memory");
    __syncthreads();
    if (threadIdx.x == 0) {
        unsigned* bar = b.bar;
        __builtin_amdgcn_s_waitcnt(0);
        unsigned nloc = b.st[0], nx = b.st[1];
        if (nloc == 0u) { xcd_barrier_complete(bar, b.x, nloc, nx); b.st[0] = nloc; b.st[1] = nx; }
        const unsigned old = xb_add(&bar[XB_XSUB(b.x)], 1u);
        const unsigned gen = old / nloc;
        if (old + 1u == (gen + 1u) * nloc) {
            __builtin_amdgcn_fence(__ATOMIC_RELEASE, "agent");
            asm volatile("s_waitcnt vmcnt(0)" ::: "memory");
            const unsigned og = xb_add(&bar[XB_TOP], 1u);
            const unsigned tg = og / nx;
            if (og + 1u == (tg + 1u) * nx) xb_add(&bar[XB_TOPGEN], 1u);
            else XB_SPIN(xb_ld(&bar[XB_TOPGEN]) == tg, bar);
            __builtin_amdgcn_fence(__ATOMIC_ACQUIRE, "agent");
            xb_add(&bar[XB_XGEN(b.x)], 1u);
            asm volatile("s_waitcnt vmcnt(0)" ::: "memory");
        } else {
            XB_SPIN(xb_ld(&bar[XB_XGEN(b.x)]) == gen, bar);
            __builtin_amdgcn_fence(__ATOMIC_ACQUIRE, "agent");
            asm volatile("s_waitcnt vmcnt(0)" ::: "memory");
        }
    }
    __syncthreads();
}

namespace pg8 {
constexpr int BM = 256, BK = 64, HALF = 128, HTB = HALF * BK * 2, STAGE_BYTES = 8 * HTB, NXCD = 8, WGM = 8;
__host__ __device__ __forceinline__ int lds_byte(int r, int c) { const int st = (r >> 4) * 2 + (c >> 5), rr = r & 15, cc = c & 31, ob = rr * 64 + cc * 2; return st * 1024 + (ob ^ (((ob >> 9) & 1) << 5)); }
__host__ __device__ __forceinline__ void stage_rc(int b, int& R, int& C) { const int st = b / 1024, sb = b % 1024, swz = sb ^ (((sb >> 9) & 1) << 5); R = (st >> 1) * 16 + swz / 64; C = (st & 1) * 32 + (swz % 64) / 2; }
__host__ __device__ __forceinline__ int perm32(int rho) { const int n = rho >> 4, i = rho & 15; return 8 * (i >> 2) + 4 * n + (i & 3); }

struct Unit { int pm, pn, aux, kind; size_t aoff, boff; };
struct Gemm { const bf16_t* A; const bf16_t* Bt; int lda, K; };

struct TileOrder {
    int nM, nN, nwg;
    __device__ void init(int M, int N) { nM = M / BM; nN = N / BM; nwg = nM * nN; }
    __device__ bool tile(long L, int& pm, int& pn) const {
        if (L >= nwg) return false;
        int wgid = (int)L; { const int q = nwg / NXCD, r = nwg % NXCD, xcd = wgid % NXCD, off = wgid / NXCD; wgid = (xcd < r ? xcd * (q + 1) : r * (q + 1) + (xcd - r) * q) + off; }
        const int nig = WGM * nN, gid = wgid / nig, fm = gid * WGM, gsz = (nM - fm) < WGM ? (nM - fm) : WGM;
        pm = fm + ((wgid % nig) % gsz); pn = (wgid % nig) / gsz; return true;
    }
};
struct PlainSched {
    TileOrder T; int G, c; size_t astep, bstep;
    __device__ void init(int M, int N, int lda, int K, int G_, int c_) { T.init(M, N); G = G_; c = c_; astep = (size_t)BM * lda * 2; bstep = (size_t)BM * K * 2; }
    __device__ bool next(int i, Unit& u) const {
        if (!T.tile((long)i * G + c, u.pm, u.pn)) return false;
        u.aux = 0; u.aoff = (size_t)u.pm * astep; u.boff = (size_t)u.pn * bstep; return true;
    }
};
struct BranchSched {
    TileOrder T; int G, c; size_t astep, bstep;
    __device__ void init(int M, int G_, int c_) { T.init(M, D); G = G_; c = c_; astep = (size_t)BM * ZLD * 2; bstep = (size_t)BM * 512 * 2; }
    __device__ bool next(int i, Unit& u) const {
        const int j = i / 3, b = i - 3 * j;
        if (!T.tile((long)j * G + c, u.pm, u.pn)) return false;
        u.aux = b; u.aoff = (size_t)u.pm * astep + (size_t)b * 512 * 2; u.boff = (size_t)(b * 4 + u.pn) * bstep; return true;
    }
};

template <bool ALIGN_EPI, bool SP2, class Epi, class Sched>
__device__ __forceinline__ void gemm_phase(LAS unsigned char* lds, const Gemm g, const Sched& S, const Epi& E) {
    const int tid = opaque_tid(), wid = __builtin_amdgcn_readfirstlane(tid >> 6), lane = tid & 63, wr = wid >> 2, wc = wid & 3, fr = lane & 15, fq = lane >> 4;
    const int K = g.K, nt = K / BK, lda = g.lda;
    unsigned voffA[2], voffB[2];
#pragma unroll
    for (int i = 0; i < 2; ++i) { int R, C; stage_rc(tid * 16 + i * 8192, R, C); const int Rb = Epi::PERM ? ((R & ~31) + perm32(R & 31)) : R;
        voffA[i] = (unsigned)(R * lda + C) * 2u; voffB[i] = (unsigned)(Rb * K + C) * 2u; }
    const size_t kstep = (size_t)(BK * 2);
    const size_t hstepA = (size_t)HALF * lda * 2, hstepB = (size_t)HALF * K * 2;
    const unsigned ldsw = (unsigned)wid * 1024u;
    const int aoff = lds_byte(wr * 64 + fr, fq * 8), boff = lds_byte(wc * 32 + fr, fq * 8);
#define PG8_SA(b, h) (((b) * 2 + (h)) * HTB)
#define PG8_SB(b, h) ((4 + (b) * 2 + (h)) * HTB)
#define PG8_STAGE(bufoff, gbase, voff) do { _Pragma("unroll") for (int _i = 0; _i < 2; ++_i) \
        __builtin_amdgcn_global_load_lds((const unsigned*)((const char*)(gbase) + (voff)[_i]), (LAS unsigned*)(lds + (bufoff) + ldsw + _i * 8192), 16, 0, 0); } while (0)
#define PG8_LDA(dst, b, h) do { _Pragma("unroll") for (int m = 0; m < 4; ++m) _Pragma("unroll") for (int k = 0; k < 2; ++k) dst[m][k] = *(const LAS bf16x8*)(lds + PG8_SA(b, h) + aoff + m * 2048 + k * 1024); } while (0)
#define PG8_LDB(dst, b, h) do { _Pragma("unroll") for (int n = 0; n < 2; ++n) _Pragma("unroll") for (int k = 0; k < 2; ++k) dst[n][k] = *(const LAS bf16x8*)(lds + PG8_SB(b, h) + boff + n * 2048 + k * 1024); } while (0)
#define PG8_MMA(ai, bj, At, Bt) do { __builtin_amdgcn_s_setprio(1); _Pragma("unroll") for (int m = 0; m < 4; ++m) _Pragma("unroll") for (int n = 0; n < 2; ++n) _Pragma("unroll") for (int k = 0; k < 2; ++k) \
        acc[ai][bj][m][n] = __builtin_amdgcn_mfma_f32_16x16x32_bf16(Bt[n][k], At[m][k], acc[ai][bj][m][n], 0, 0, 0); __builtin_amdgcn_s_setprio(0); } while (0)
#define PG8_WAIT_V(n) asm volatile("s_waitcnt vmcnt(" #n ")" ::: "memory")
#define PG8_WAIT_L(n) asm volatile("s_waitcnt lgkmcnt(" #n ")" ::: "memory")
#define PG8_BAR __builtin_amdgcn_s_barrier()
#define PG8_SCHED __builtin_amdgcn_sched_barrier(0)
    Unit cur, nxt; int ui = 0;
    if (!S.next(0, cur)) return;
    f32x4 acc[2][2][4][2];
#pragma unroll
    for (int a = 0; a < 2; ++a)
#pragma unroll
        for (int b = 0; b < 2; ++b)
#pragma unroll
            for (int m = 0; m < 4; ++m)
#pragma unroll
                for (int n = 0; n < 2; ++n) acc[a][b][m][n] = (f32x4){0.f, 0.f, 0.f, 0.f};
    bf16x8 At[4][2], B0[2][2], B1[2][2];
    const char* cA = (const char*)g.A + cur.aoff; const char* cB = (const char*)g.Bt + cur.boff;
    typename Epi::Pre pre = E.prefetch(cur, wr, fr);
    if constexpr (SP2) {
        PG8_STAGE(PG8_SB(0, 0), cB, voffB); PG8_STAGE(PG8_SB(0, 1), cB + hstepB, voffB); PG8_STAGE(PG8_SA(0, 0), cA, voffA); PG8_STAGE(PG8_SA(0, 1), cA + hstepA, voffA);
        if (wr == 1) PG8_BAR;
        PG8_WAIT_V(2); PG8_BAR;
        PG8_STAGE(PG8_SB(1, 0), cB + kstep, voffB); PG8_STAGE(PG8_SA(1, 0), cA + kstep, voffA); PG8_STAGE(PG8_SB(1, 1), cB + hstepB + kstep, voffB);
        PG8_WAIT_V(6); PG8_BAR;
    } else {
        PG8_STAGE(PG8_SB(0, 0), cB, voffB); PG8_STAGE(PG8_SA(0, 0), cA, voffA); PG8_STAGE(PG8_SB(0, 1), cB + hstepB, voffB); PG8_STAGE(PG8_SA(0, 1), cA + hstepA, voffA);
        if (wr == 1) PG8_BAR;
        PG8_WAIT_V(4); PG8_BAR;
        PG8_STAGE(PG8_SB(1, 0), cB + kstep, voffB); PG8_STAGE(PG8_SA(1, 0), cA + kstep, voffA); PG8_STAGE(PG8_SB(1, 1), cB + hstepB + kstep, voffB);
        PG8_WAIT_V(6); PG8_BAR;
    }
    for (;;) {
        const bool has_next = S.next(ui + 1, nxt);
        const char* nA = has_next ? (const char*)g.A + nxt.aoff : cA; const char* nB = has_next ? (const char*)g.Bt + nxt.boff : cB;
        for (int t = 0; t < nt; t += 2) {
            const bool last = (t == nt - 2);
            const char* a1 = cA + (size_t)(t + 1) * kstep;
            const char* a2 = last ? nA : cA + (size_t)(t + 2) * kstep; const char* b2 = last ? nB : cB + (size_t)(t + 2) * kstep;
            const char* a3 = a2 + kstep; const char* b3 = b2 + kstep;
            if constexpr (SP2) {
            PG8_LDB(B0, 0, 0); PG8_LDB(B1, 0, 1); PG8_SCHED; PG8_LDA(At, 0, 0); PG8_STAGE(PG8_SA(1, 1), a1 + hstepA, voffA);
            PG8_WAIT_V(8); PG8_WAIT_L(0); PG8_BAR; PG8_MMA(0, 0, At, B0); PG8_MMA(0, 1, At, B1); PG8_BAR; PG8_SCHED;
            PG8_LDA(At, 0, 1); PG8_STAGE(PG8_SB(0, 0), b2, voffB); PG8_STAGE(PG8_SB(0, 1), b2 + hstepB, voffB); PG8_STAGE(PG8_SA(0, 0), a2, voffA);
            PG8_WAIT_V(8); PG8_WAIT_L(0); PG8_BAR; PG8_MMA(1, 0, At, B0); PG8_MMA(1, 1, At, B1); PG8_BAR; PG8_SCHED;
            PG8_LDB(B0, 1, 0); PG8_LDB(B1, 1, 1); PG8_SCHED; PG8_LDA(At, 1, 0); PG8_STAGE(PG8_SA(0, 1), a2 + hstepA, voffA);
            PG8_WAIT_V(8); PG8_WAIT_L(0); PG8_BAR; PG8_MMA(0, 0, At, B0); PG8_MMA(0, 1, At, B1); PG8_BAR; PG8_SCHED;
            PG8_LDA(At, 1, 1); PG8_STAGE(PG8_SB(1, 0), b3, voffB); PG8_STAGE(PG8_SB(1, 1), b3 + hstepB, voffB); PG8_STAGE(PG8_SA(1, 0), a3, voffA);
            PG8_WAIT_V(8); PG8_WAIT_L(0); PG8_BAR; PG8_MMA(1, 0, At, B0); PG8_MMA(1, 1, At, B1); PG8_BAR; PG8_SCHED;
            } else {
            PG8_LDB(B0, 0, 0); PG8_SCHED; PG8_LDA(At, 0, 0); PG8_STAGE(PG8_SA(1, 1), a1 + hstepA, voffA);
            PG8_WAIT_L(8); PG8_BAR; PG8_WAIT_L(0); PG8_MMA(0, 0, At, B0); PG8_BAR; PG8_SCHED;
            PG8_LDB(B1, 0, 1); PG8_STAGE(PG8_SB(0, 0), b2, voffB);
            PG8_BAR; PG8_WAIT_L(0); PG8_MMA(0, 1, At, B1); PG8_BAR;
            PG8_LDA(At, 0, 1); PG8_STAGE(PG8_SA(0, 0), a2, voffA);
            PG8_BAR; PG8_WAIT_L(0); PG8_MMA(1, 0, At, B0); PG8_BAR; PG8_SCHED;
            PG8_STAGE(PG8_SB(0, 1), b2 + hstepB, voffB);
            PG8_WAIT_V(6); PG8_BAR; PG8_MMA(1, 1, At, B1); PG8_BAR;
            PG8_LDB(B0, 1, 0); PG8_SCHED; PG8_LDA(At, 1, 0); PG8_STAGE(PG8_SA(0, 1), a2 + hstepA, voffA);
            PG8_WAIT_L(8); PG8_BAR; PG8_WAIT_L(0); PG8_MMA(0, 0, At, B0); PG8_BAR; PG8_SCHED;
            PG8_LDB(B1, 1, 1); PG8_STAGE(PG8_SB(1, 0), b3, voffB);
            PG8_BAR; PG8_WAIT_L(0); PG8_MMA(0, 1, At, B1); PG8_BAR;
            PG8_LDA(At, 1, 1); PG8_STAGE(PG8_SA(1, 0), a3, voffA);
            PG8_BAR; PG8_WAIT_L(0); PG8_MMA(1, 0, At, B0); PG8_BAR; PG8_SCHED;
            PG8_STAGE(PG8_SB(1, 1), b3 + hstepB, voffB);
            PG8_WAIT_V(6); PG8_BAR; PG8_MMA(1, 1, At, B1); PG8_BAR;
            }
        }
        if constexpr (ALIGN_EPI) { if (wr == 0) PG8_BAR; }
        E(acc, cur, wr, wc, fr, fq, pre);
        if (!has_next) break;
#pragma unroll
        for (int a = 0; a < 2; ++a)
#pragma unroll
            for (int b = 0; b < 2; ++b)
#pragma unroll
                for (int m = 0; m < 4; ++m)
#pragma unroll
                    for (int n = 0; n < 2; ++n) acc[a][b][m][n] = (f32x4){0.f, 0.f, 0.f, 0.f};
        cur = nxt; cA = nA; cB = nB; ++ui;
        pre = E.prefetch(cur, wr, fr);
        if constexpr (ALIGN_EPI) { if (wr == 1) PG8_BAR; }
    }
    PG8_WAIT_V(0);
    if constexpr (!ALIGN_EPI) { if (wr == 0) PG8_BAR; }
    PG8_BAR;
#undef PG8_SA
#undef PG8_SB
#undef PG8_STAGE
#undef PG8_LDA
#undef PG8_LDB
#undef PG8_MMA
#undef PG8_WAIT_V
#undef PG8_WAIT_L
#undef PG8_BAR
#undef PG8_SCHED
}

struct Epi1 {
    static constexpr bool PERM = true;
    bf16_t* Z; const float* rinv; bf16_t* HM;
    struct Pre { float rs[2][4]; };
    __device__ __forceinline__ Pre prefetch(const Unit& u, int wr, int fr) const {
        Pre p; const int row0 = u.pm * BM + wr * 64 + fr;
#pragma unroll
        for (int ai = 0; ai < 2; ++ai)
#pragma unroll
            for (int m = 0; m < 4; ++m) p.rs[ai][m] = rinv[row0 + ai * HALF + m * 16];
        return p;
    }
    __device__ __forceinline__ void operator()(const f32x4 (&acc)[2][2][4][2], const Unit& u, int wr, int wc, int fr, int fq, const Pre& pre) const {
        const int row0 = u.pm * BM + wr * 64 + fr; const int pn = u.pn;
        const float (&rsv)[2][4] = pre.rs;
        if (pn < 4) {
            const int col = COL_U + pn * 128 + wc * 32 + 8 * fq;
#pragma unroll
            for (int ai = 0; ai < 2; ++ai)
#pragma unroll
                for (int m = 0; m < 4; ++m) { const int row = row0 + ai * HALF + m * 16; const float rs = rsv[ai][m];
                    float o[8];
#pragma unroll
                    for (int n = 0; n < 2; ++n)
#pragma unroll
                        for (int j = 0; j < 4; ++j) o[4 * n + j] = acc[ai][0][m][n][j] * rs * sigmoidf_(acc[ai][1][m][n][j] * rs);
                    u32x4 v; v.x = pk2(o[0], o[1]); v.y = pk2(o[2], o[3]); v.z = pk2(o[4], o[5]); v.w = pk2(o[6], o[7]);
                    *(u32x4*)(Z + (size_t)row * ZLD + col) = v; }
        } else {
            int dcol, act;
            if (pn >= 6 && pn < 14) {
                const int seg = (pn - 6) >> 1, cseg = (pn & 1) * 256 + wc * 32 + 8 * fq, b = row0 >> 11, t0 = row0 & (SEQ - 1);
                bf16_t* hp = HM + (size_t)seg * HMSEG + ((size_t)(b * 8 + (cseg >> 6)) * SEQ + t0) * 64 + (cseg & 63);
                if (seg == 0) store_act<2, true>(acc, rsv, hp); else if (seg == 3) store_act<1, true>(acc, rsv, hp); else store_act<0, true>(acc, rsv, hp);
                return;
            }
            if (pn < 6) { dcol = COL_CG + (pn - 4) * 256; act = 1; }
            else if (pn < 16) { dcol = COL_P + (pn - 14) * 256; act = 0; }
            else if (pn < 18) { dcol = COL_PG + (pn - 16) * 256; act = 1; }
            else { dcol = COL_GM + (pn - 18) * 256; act = 3; }
            bf16_t* zp = Z + (size_t)row0 * ZLD + dcol + wc * 32 + 8 * fq;
            if (act == 0) store_act<0, false>(acc, rsv, zp); else if (act == 1) store_act<1, false>(acc, rsv, zp); else store_act<3, false>(acc, rsv, zp);
        }
    }
    template <int ACT, bool HEADM> static __device__ __forceinline__ void store_act(const f32x4 (&acc)[2][2][4][2], const float (&rsv)[2][4], bf16_t* zp) {
#pragma unroll
        for (int ai = 0; ai < 2; ++ai)
#pragma unroll
            for (int m = 0; m < 4; ++m) { const float rs = rsv[ai][m];
#pragma unroll
                for (int bj = 0; bj < 2; ++bj) { float o[8];
#pragma unroll
                    for (int n = 0; n < 2; ++n)
#pragma unroll
                        for (int j = 0; j < 4; ++j) { float z = acc[ai][bj][m][n][j] * rs;
                            if (ACT == 1) z = z * sigmoidf_(z); else if (ACT == 2) z = z * 0.18033688011112042f  ; else if (ACT == 3) z = sigmoidf_(z);
                            o[4 * n + j] = z; }
                    u32x4 v; v.x = pk2(o[0], o[1]); v.y = pk2(o[2], o[3]); v.z = pk2(o[4], o[5]); v.w = pk2(o[6], o[7]);
                    if (HEADM) *(u32x4*)(zp + (size_t)(ai * HALF + m * 16) * 64 + (size_t)bj * 2 * SEQ * 64) = v;
                    else *(u32x4*)(zp + (size_t)(ai * HALF + m * 16) * ZLD + bj * HALF) = v; } }
    }
};
struct Epi3 {
    static constexpr bool PERM = true;
    const bf16_t* Z; bf16_t* MG;
    struct Pre {};
    __device__ __forceinline__ Pre prefetch(const Unit&, int, int) const { return Pre{}; }
    __device__ __forceinline__ void operator()(const f32x4 (&acc)[2][2][4][2], const Unit& u, int wr, int wc, int fr, int fq, const Pre&) const {
        const int row0 = u.pm * BM + wr * 64 + fr; const int b = u.aux;
        const int col0 = u.pn * BM + wc * 32 + 8 * fq;
        const bf16_t* gbase = Z + (size_t)row0 * ZLD + COL_GM + b * D + col0;
        bf16_t* mbase = MG + (size_t)row0 * D + col0;
#pragma unroll
        for (int ai = 0; ai < 2; ++ai) {
            u32x4 gv[4][2], pv[4][2];
#pragma unroll
            for (int m = 0; m < 4; ++m)
#pragma unroll
                for (int bj = 0; bj < 2; ++bj) gv[m][bj] = *(const u32x4*)(gbase + (size_t)(ai * HALF + m * 16) * ZLD + bj * HALF);
            if (b > 0) {
#pragma unroll
                for (int m = 0; m < 4; ++m)
#pragma unroll
                    for (int bj = 0; bj < 2; ++bj) pv[m][bj] = *(const u32x4*)(mbase + (size_t)(ai * HALF + m * 16) * D + bj * HALF);
            } else {
#pragma unroll
                for (int m = 0; m < 4; ++m)
#pragma unroll
                    for (int bj = 0; bj < 2; ++bj) pv[m][bj] = (u32x4){0u, 0u, 0u, 0u};
            }
#pragma unroll
            for (int m = 0; m < 4; ++m)
#pragma unroll
                for (int bj = 0; bj < 2; ++bj) { const u32x4 g = gv[m][bj], q = pv[m][bj];
                    float o[8];
                    o[0] = acc[ai][bj][m][0][0] * bflo(g.x) + bflo(q.x); o[1] = acc[ai][bj][m][0][1] * bfhi(g.x) + bfhi(q.x); o[2] = acc[ai][bj][m][0][2] * bflo(g.y) + bflo(q.y); o[3] = acc[ai][bj][m][0][3] * bfhi(g.y) + bfhi(q.y);
                    o[4] = acc[ai][bj][m][1][0] * bflo(g.z) + bflo(q.z); o[5] = acc[ai][bj][m][1][1] * bfhi(g.z) + bfhi(q.z); o[6] = acc[ai][bj][m][1][2] * bflo(g.w) + bflo(q.w); o[7] = acc[ai][bj][m][1][3] * bfhi(g.w) + bfhi(q.w);
                    u32x4 v; v.x = pk2(o[0], o[1]); v.y = pk2(o[2], o[3]); v.z = pk2(o[4], o[5]); v.w = pk2(o[6], o[7]);
                    *(u32x4*)(mbase + (size_t)(ai * HALF + m * 16) * D + bj * HALF) = v; }
        }
    }
};
struct Epi4 {
    static constexpr bool PERM = true;
    bf16_t* Y; float* part;
    struct Pre {};
    __device__ __forceinline__ Pre prefetch(const Unit&, int, int) const { return Pre{}; }
    __device__ __forceinline__ void operator()(const f32x4 (&acc)[2][2][4][2], const Unit& u, int wr, int wc, int fr, int fq, const Pre&) const {
        const int row0 = u.pm * BM + wr * 64 + fr; const int col0 = u.pn * BM + wc * 32 + 8 * fq;
#pragma unroll
        for (int ai = 0; ai < 2; ++ai)
#pragma unroll
            for (int m = 0; m < 4; ++m) { const int row = row0 + ai * HALF + m * 16; float ss = 0.f;
#pragma unroll
                for (int bj = 0; bj < 2; ++bj) { const f32x4 a0 = acc[ai][bj][m][0], a1 = acc[ai][bj][m][1];
                    ss += a0[0] * a0[0] + a0[1] * a0[1] + a0[2] * a0[2] + a0[3] * a0[3] + a1[0] * a1[0] + a1[1] * a1[1] + a1[2] * a1[2] + a1[3] * a1[3];
                    u32x4 v; v.x = pk2(a0[0], a0[1]); v.y = pk2(a0[2], a0[3]); v.z = pk2(a1[0], a1[1]); v.w = pk2(a1[2], a1[3]);
                    *(u32x4*)(Y + (size_t)row * D + col0 + bj * HALF) = v; }
                ss += __shfl_xor(ss, 16); ss += __shfl_xor(ss, 32);
                if (fq == 0) part[(size_t)row * 16 + u.pn * 4 + wc] = ss; }
    }
};
struct Gemm2 { const bf16_t* A; const bf16_t* A2; const bf16_t* Bt; int lda, lda2, K; };
template <class Epi, class Sched>
__device__ __forceinline__ void gemm_phase_mix(LAS unsigned char* lds, const Gemm2 g, const Sched& S, const Epi& E) {
    const int tid = opaque_tid(), wid = __builtin_amdgcn_readfirstlane(tid >> 6), lane = tid & 63, wr = wid >> 2, wc = wid & 3, fr = lane & 15, fq = lane >> 4;
    const int K = g.K, nt = K / BK;
    unsigned voffA0, voffA20, voffB0;
    { int R, C; stage_rc(tid * 16, R, C); const int Rb = (R & ~31) + perm32(R & 31);
      voffA0 = (unsigned)(R * g.lda + C) * 2u; voffA20 = (unsigned)(R * g.lda2 + C) * 2u; voffB0 = (unsigned)(Rb * K + C) * 2u; }
    const unsigned p1A = 64u * g.lda * 2u, p1A2 = 64u * g.lda2 * 2u, p1B = 64u * K * 2u;
    const size_t kstep = (size_t)(BK * 2);
    const size_t hstepA = (size_t)HALF * g.lda * 2, hstepA2 = (size_t)HALF * g.lda2 * 2, hstepB = (size_t)HALF * K * 2;
    const unsigned ldsw = (unsigned)wid * 1024u;
    const int aoff = lds_byte(wr * 64 + fr, fq * 8), boff = lds_byte(wc * 32 + fr, fq * 8);
#define PG8_SA(b, h) (((b) * 2 + (h)) * HTB)
#define PG8_SB(b, h) ((4 + (b) * 2 + (h)) * HTB)
#define PG8_STAGE(bufoff, gbase, voff) do { _Pragma("unroll") for (int _i = 0; _i < 2; ++_i) \
        __builtin_amdgcn_global_load_lds((const unsigned*)((const char*)(gbase) + (size_t)_i * p1B + voffB0), (LAS unsigned*)(lds + (bufoff) + ldsw + _i * 8192), 16, 0, 0); } while (0)
#define PG8_STAGE_A(bufoff, gbase, k2) do { const unsigned _v = (k2) ? voffA20 : voffA0; const size_t _p = (k2) ? p1A2 : p1A; _Pragma("unroll") for (int _i = 0; _i < 2; ++_i) \
        __builtin_amdgcn_global_load_lds((const unsigned*)((const char*)(gbase) + (size_t)_i * _p + _v), (LAS unsigned*)(lds + (bufoff) + ldsw + _i * 8192), 16, 0, 0); } while (0)
#define PG8_LDA(dst, b, h) do { _Pragma("unroll") for (int m = 0; m < 4; ++m) _Pragma("unroll") for (int k = 0; k < 2; ++k) dst[m][k] = *(const LAS bf16x8*)(lds + PG8_SA(b, h) + aoff + m * 2048 + k * 1024); } while (0)
#define PG8_LDB(dst, b, h) do { _Pragma("unroll") for (int n = 0; n < 2; ++n) _Pragma("unroll") for (int k = 0; k < 2; ++k) dst[n][k] = *(const LAS bf16x8*)(lds + PG8_SB(b, h) + boff + n * 2048 + k * 1024); } while (0)
#define PG8_MMA(ai, bj, At, Bt) do { __builtin_amdgcn_s_setprio(1); _Pragma("unroll") for (int m = 0; m < 4; ++m) _Pragma("unroll") for (int n = 0; n < 2; ++n) _Pragma("unroll") for (int k = 0; k < 2; ++k) \
        acc[ai][bj][m][n] = __builtin_amdgcn_mfma_f32_16x16x32_bf16(Bt[n][k], At[m][k], acc[ai][bj][m][n], 0, 0, 0); __builtin_amdgcn_s_setprio(0); } while (0)
#define PG8_WAIT_V(n) asm volatile("s_waitcnt vmcnt(" #n ")" ::: "memory")
#define PG8_WAIT_L(n) asm volatile("s_waitcnt lgkmcnt(" #n ")" ::: "memory")
#define PG8_BAR __builtin_amdgcn_s_barrier()
#define PG8_SCHED __builtin_amdgcn_sched_barrier(0)
    Unit cur, nxt; int ui = 0;
    if (!S.next(0, cur)) return;
    f32x4 acc[2][2][4][2];
#pragma unroll
    for (int a = 0; a < 2; ++a)
#pragma unroll
        for (int b = 0; b < 2; ++b)
#pragma unroll
            for (int m = 0; m < 4; ++m)
#pragma unroll
                for (int n = 0; n < 2; ++n) acc[a][b][m][n] = (f32x4){0.f, 0.f, 0.f, 0.f};
    bf16x8 At[4][2], B0[2][2], B1[2][2];
    bool ck = cur.kind < 2;
    const char* cA = (ck ? (const char*)g.A2 : (const char*)g.A) + cur.aoff; const char* cB = (const char*)g.Bt + cur.boff;
    size_t chA = ck ? hstepA2 : hstepA;
    PG8_STAGE(PG8_SB(0, 0), cB, voffB); PG8_STAGE(PG8_SB(0, 1), cB + hstepB, voffB); PG8_STAGE_A(PG8_SA(0, 0), cA, ck); PG8_STAGE_A(PG8_SA(0, 1), cA + chA, ck);
    if (wr == 1) PG8_BAR;
    PG8_WAIT_V(2); PG8_BAR;
    PG8_STAGE(PG8_SB(1, 0), cB + kstep, voffB); PG8_STAGE_A(PG8_SA(1, 0), cA + kstep, ck); PG8_STAGE(PG8_SB(1, 1), cB + hstepB + kstep, voffB);
    PG8_WAIT_V(6); PG8_BAR;
    for (;;) {
        const bool has_next = S.next(ui + 1, nxt);
        const bool nk = has_next ? (nxt.kind < 2) : ck;
        const char* nA = has_next ? (nk ? (const char*)g.A2 : (const char*)g.A) + nxt.aoff : cA; const char* nB = has_next ? (const char*)g.Bt + nxt.boff : cB;
        const size_t nhA = nk ? hstepA2 : hstepA;
        for (int t = 0; t < nt; t += 2) {
            const bool last = (t == nt - 2);
            const char* a1 = cA + (size_t)(t + 1) * kstep;
            const char* a2 = last ? nA : cA + (size_t)(t + 2) * kstep; const char* b2 = last ? nB : cB + (size_t)(t + 2) * kstep;
            const bool k2 = last ? nk : ck; const size_t h2 = last ? nhA : chA;
            const char* a3 = a2 + kstep; const char* b3 = b2 + kstep;
            PG8_LDB(B0, 0, 0); PG8_LDB(B1, 0, 1); PG8_SCHED; PG8_LDA(At, 0, 0); PG8_STAGE_A(PG8_SA(1, 1), a1 + chA, ck);
            PG8_WAIT_V(8); PG8_WAIT_L(0); PG8_BAR; PG8_MMA(0, 0, At, B0); PG8_MMA(0, 1, At, B1); PG8_BAR; PG8_SCHED;
            PG8_LDA(At, 0, 1); PG8_STAGE(PG8_SB(0, 0), b2, voffB); PG8_STAGE(PG8_SB(0, 1), b2 + hstepB, voffB); PG8_STAGE_A(PG8_SA(0, 0), a2, k2);
            PG8_WAIT_V(8); PG8_WAIT_L(0); PG8_BAR; PG8_MMA(1, 0, At, B0); PG8_MMA(1, 1, At, B1); PG8_BAR; PG8_SCHED;
            PG8_LDB(B0, 1, 0); PG8_LDB(B1, 1, 1); PG8_SCHED; PG8_LDA(At, 1, 0); PG8_STAGE_A(PG8_SA(0, 1), a2 + h2, k2);
            PG8_WAIT_V(8); PG8_WAIT_L(0); PG8_BAR; PG8_MMA(0, 0, At, B0); PG8_MMA(0, 1, At, B1); PG8_BAR; PG8_SCHED;
            PG8_LDA(At, 1, 1); PG8_STAGE(PG8_SB(1, 0), b3, voffB); PG8_STAGE(PG8_SB(1, 1), b3 + hstepB, voffB); PG8_STAGE_A(PG8_SA(1, 0), a3, k2);
            PG8_WAIT_V(8); PG8_WAIT_L(0); PG8_BAR; PG8_MMA(1, 0, At, B0); PG8_MMA(1, 1, At, B1); PG8_BAR; PG8_SCHED;
        }
        const bool epi = (cur.kind != 0);
        if (epi) {
            if (wr == 0) PG8_BAR;
            E(acc, cur, wr, wc, fr, fq);
        }
        if (!has_next) break;
        if (epi) {
#pragma unroll
            for (int a = 0; a < 2; ++a)
#pragma unroll
                for (int b = 0; b < 2; ++b)
#pragma unroll
                    for (int m = 0; m < 4; ++m)
#pragma unroll
                        for (int n = 0; n < 2; ++n) acc[a][b][m][n] = (f32x4){0.f, 0.f, 0.f, 0.f};
        }
        cur = nxt; cA = nA; cB = nB; ck = nk; chA = nhA; ++ui;
        if (epi) { if (wr == 1) PG8_BAR; }
    }
    PG8_WAIT_V(0);
    PG8_BAR;
#undef PG8_SA
#undef PG8_SB
#undef PG8_STAGE
#undef PG8_STAGE_A
#undef PG8_LDA
#undef PG8_LDB
#undef PG8_MMA
#undef PG8_WAIT_V
#undef PG8_WAIT_L
#undef PG8_BAR
#undef PG8_SCHED
}
struct BranchSched2 {
    TileOrder T; int G, c;
    __device__ void init(int M, int G_, int c_) { T.init(M, D); G = G_; c = c_; }
    __device__ bool next(int i, Unit& u) const {
        const int j = i / 9, s = i - 9 * j, b = s / 3, w = s - 3 * b;
        if (!T.tile((long)j * G + c, u.pm, u.pn)) return false;
        u.aux = b; u.kind = w;
        if (w < 2) { u.aoff = (size_t)u.pm * BM * D * 2 + (size_t)w * 512 * 2; u.boff = (size_t)((b * 2 + w) * 1024 + u.pn * BM) * 512 * 2; }
        else { u.aoff = (size_t)u.pm * BM * ZLD * 2 + (size_t)b * 512 * 2; u.boff = (size_t)(6144 + b * 1024 + u.pn * BM) * 512 * 2; }
        return true;
    }
};
struct EpiGY {
    static constexpr bool PERM = true;
    bf16_t* S; const float* rinv; bf16_t* MG;
    __device__ __forceinline__ void operator()(const f32x4 (&acc)[2][2][4][2], const Unit& u, int wr, int wc, int fr, int fq) const {
        bf16_t* s0 = S; asm volatile("" : "+s"(s0));
        bf16_t* sp = s0 + (wr * 64 + fr) * 256 + wc * 32 + 8 * fq;
        if (u.kind == 1) {
            const int row0 = u.pm * BM + wr * 64 + fr;
            float rs[2][4];
#pragma unroll
            for (int ai = 0; ai < 2; ++ai)
#pragma unroll
                for (int m = 0; m < 4; ++m) rs[ai][m] = rinv[row0 + ai * HALF + m * 16];
#pragma unroll
            for (int ai = 0; ai < 2; ++ai)
#pragma unroll
                for (int m = 0; m < 4; ++m)
#pragma unroll
                    for (int bj = 0; bj < 2; ++bj) { float o[8];
#pragma unroll
                        for (int n = 0; n < 2; ++n)
#pragma unroll
                            for (int j = 0; j < 4; ++j) o[4 * n + j] = sigmoidf_(acc[ai][bj][m][n][j] * rs[ai][m]);
                        u32x4 v; v.x = pk2(o[0], o[1]); v.y = pk2(o[2], o[3]); v.z = pk2(o[4], o[5]); v.w = pk2(o[6], o[7]);
                        *(u32x4*)(sp + (ai * HALF + m * 16) * 256 + bj * HALF) = v; }
        } else {
            const int b = u.aux;
            bf16_t* mbase = MG + (size_t)(u.pm * BM + wr * 64 + fr) * D + u.pn * BM + wc * 32 + 8 * fq;
#pragma unroll
            for (int ai = 0; ai < 2; ++ai) {
                u32x4 gv[4][2], pv[4][2];
#pragma unroll
                for (int m = 0; m < 4; ++m)
#pragma unroll
                    for (int bj = 0; bj < 2; ++bj) gv[m][bj] = *(const u32x4*)(sp + (ai * HALF + m * 16) * 256 + bj * HALF);
                if (b > 0) {
#pragma unroll
                    for (int m = 0; m < 4; ++m)
#pragma unroll
                        for (int bj = 0; bj < 2; ++bj) pv[m][bj] = *(const u32x4*)(mbase + (size_t)(ai * HALF + m * 16) * D + bj * HALF);
                } else {
#pragma unroll
                    for (int m = 0; m < 4; ++m)
#pragma unroll
                        for (int bj = 0; bj < 2; ++bj) pv[m][bj] = (u32x4){0u, 0u, 0u, 0u};
                }
#pragma unroll
                for (int m = 0; m < 4; ++m)
#pragma unroll
                    for (int bj = 0; bj < 2; ++bj) { const u32x4 g = gv[m][bj], q = pv[m][bj];
                        float o[8];
                        o[0] = acc[ai][bj][m][0][0] * bflo(g.x) + bflo(q.x); o[1] = acc[ai][bj][m][0][1] * bfhi(g.x) + bfhi(q.x); o[2] = acc[ai][bj][m][0][2] * bflo(g.y) + bflo(q.y); o[3] = acc[ai][bj][m][0][3] * bfhi(g.y) + bfhi(q.y);
                        o[4] = acc[ai][bj][m][1][0] * bflo(g.z) + bflo(q.z); o[5] = acc[ai][bj][m][1][1] * bfhi(g.z) + bfhi(q.z); o[6] = acc[ai][bj][m][1][2] * bflo(g.w) + bflo(q.w); o[7] = acc[ai][bj][m][1][3] * bfhi(g.w) + bfhi(q.w);
                        u32x4 v; v.x = pk2(o[0], o[1]); v.y = pk2(o[2], o[3]); v.z = pk2(o[4], o[5]); v.w = pk2(o[6], o[7]);
                        *(u32x4*)(mbase + (size_t)(ai * HALF + m * 16) * D + bj * HALF) = v; }
            }
        }
    }
};
}

__device__ __forceinline__ void tr_wave(const float* src, int ld, int k0, int c0, bf16_t* dst, int ldd, int n0, int kd0, const float* gk, LAS float* scr, int lane) {
    const int cc = lane & 31, kh = lane >> 5;
#pragma unroll 8
    for (int i = 0; i < 32; ++i) { const int kk = 2 * i + kh; float v = src[(size_t)(k0 + kk) * ld + c0 + cc]; if (gk) v *= gk[k0 + kk]; scr[kk * 33 + cc] = v; }
    asm volatile("s_waitcnt lgkmcnt(0)" ::: "memory");
    const int c = lane & 7;
#pragma unroll
    for (int j = 0; j < 4; ++j) { const int n = (lane >> 3) + 8 * j; const LAS float* q = scr + (8 * c) * 33 + n;
        u32x4 o; o.x = pk2(q[0], q[33]); o.y = pk2(q[2 * 33], q[3 * 33]); o.z = pk2(q[4 * 33], q[5 * 33]); o.w = pk2(q[6 * 33], q[7 * 33]);
        *(u32x4*)(dst + (size_t)(n0 + n) * ldd + kd0 + 8 * c) = o; }
    asm volatile("s_waitcnt lgkmcnt(0)" ::: "memory");
}
__device__ __forceinline__ int win_srccol(int n) {
    if (n >= 1024) return n;
    const int pn = n >> 8, i = n & 255; return (i < 128) ? (128 * pn + i) : (512 + 128 * pn + (i - 128));
}
__device__ __forceinline__ void phase0(CP* pp, LAS unsigned char* lds) {
    const int tid = opaque_tid(), G = gridDim.x, bid = blockIdx.x;
    LAS float* scr = (LAS float*)lds;
    bf16_t* WinT = (bf16_t*)(pp->ws + WS_WIN); bf16_t* WGY = (bf16_t*)(pp->ws + WS_WGY); bf16_t* WoutT = (bf16_t*)(pp->ws + WS_WOUT); bf16_t* WpoolT = (bf16_t*)(pp->ws + WS_WPOOL);
    constexpr int I_IN = 16 * 240, I_BR = 8 * 32, I_OUT = 16 * 32, I_PW = 2 * 4, I_L = I_IN + 3 * I_BR + I_OUT + 4 * I_PW;
    { const int wv = __builtin_amdgcn_readfirstlane(tid >> 6), ln = tid & 63;
      LAS float* wscr = scr + wv * (64 * 33);
      for (int it = bid * 8 + wv; it < 2 * I_L; it += G * 8) {
        const int l = it / I_L; int r = it - l * I_L;
        if (r < I_IN) { const int kb = r / 240, nb = r % 240;
            if (nb * 32 < NIN1) tr_wave(pp->in[3] + (size_t)l * D * NIN, NIN, kb * 64, win_srccol(nb * 32), WinT + (size_t)l * NIN * D, D, nb * 32, kb * 64, pp->in[1] + l * D, wscr, ln);
            else { const int ng = nb * 32 - NIN1, b = ng >> 10, kh = kb >> 3;
                tr_wave(pp->in[3] + (size_t)l * D * NIN, NIN, kb * 64, nb * 32, WGY + ((size_t)l * 9216 + (b * 2 + kh) * 1024) * 512, 512, ng & 1023, (kb & 7) * 64, pp->in[1] + l * D, wscr, ln); }
            continue; }
        r -= I_IN;
        if (r < 3 * I_BR) { const int b = r / I_BR, q = r % I_BR, kb = q / 32, nb = q % 32; const float* src = pp->in[b == 0 ? 8 : (b == 1 ? 10 : 14)] + (size_t)l * 512 * D;
            tr_wave(src, D, kb * 64, nb * 32, WGY + ((size_t)l * 9216 + 6144 + b * 1024) * 512, 512, nb * 32, kb * 64, nullptr, wscr, ln); continue; }
        r -= 3 * I_BR;
        if (r < I_OUT) { const int kb = r / 32, nb = r % 32; tr_wave(pp->in[15] + (size_t)l * D * D, D, kb * 64, nb * 32, WoutT + (size_t)l * D * D, D, nb * 32, kb * 64, nullptr, wscr, ln); continue; }
        r -= I_OUT;
        { const int g = r >> 3, kb = (r >> 2) & 1, nb = r & 3; tr_wave(pp->in[11] + ((size_t)l * 4 + g) * 128 * 128, 128, kb * 64, nb * 32, WpoolT + ((size_t)l * 4 + g) * 128 * 128, 128, nb * 32, kb * 64, nullptr, wscr, ln); }
      }
    }
    const int wid = tid >> 6, lane = tid & 63;
    bf16_t* xb = (bf16_t*)(pp->ws + WS_XB); float* rinv = (float*)(pp->ws + WS_RINV);
    for (int row = bid * 8 + wid; row < NTOK; row += G * 8) {
        const f32x4* xr = (const f32x4*)(pp->in[0] + (size_t)row * D) + lane; float ss = 0.f;
        u32x2* o = (u32x2*)(xb + (size_t)row * D) + lane;
#pragma unroll
        for (int j = 0; j < 4; ++j) { const f32x4 v = xr[64 * j]; ss += v.x * v.x + v.y * v.y + v.z * v.z + v.w * v.w; u32x2 w; w.x = pk2(v.x, v.y); w.y = pk2(v.z, v.w); o[64 * j] = w; }
        ss = wave_sum(ss);
        if (lane == 0) rinv[row] = rsqrtf(ss * (1.f / D) + EPS);
    }
}

__device__ __forceinline__ void lds_barrier() { asm volatile("s_waitcnt lgkmcnt(0)" ::: "memory"); __builtin_amdgcn_s_barrier(); asm volatile("" ::: "memory"); }
__device__ __forceinline__ void conv_phase(CP* pp, int l, bf16_t* Z, LAS unsigned char* lds) {
    const int G = gridDim.x, bid = blockIdx.x;
    const int tid = opaque_tid(), wid = tid >> 6, lane = tid & 63;
    constexpr int NT = MC / 32;
    if (bid >= NT) return;
    LAS bf16_t* us = (LAS bf16_t*)lds;
    LAS float* vs = (LAS float*)(lds + 63488);
    typedef float f32x2 __attribute__((ext_vector_type(2)));
    const int cp = tid & 255, th = tid >> 8;
    const float* dw = pp->in[4] + (size_t)l * 31 * 512 + 2 * cp;
    f32x2 w[31];
#pragma unroll
    for (int j = 0; j < 31; ++j) w[j] = *(const f32x2*)(dw + j * 512);
    const f32x2 bias = *(const f32x2*)(pp->in[5] + l * 512 + 2 * cp);
    const float* lg = pp->in[6] + l * 512 + lane * 8; const float* lb = pp->in[7] + l * 512 + lane * 8;
#define CONV_LOAD(tile_, st_, gate_) do { const int bl_ = (tile_) >> 6, t0_ = ((tile_) & 63) * 32; const size_t rb_ = (size_t)bl_ * SEQ; \
        _Pragma("unroll") for (int k = 0; k < 8; ++k) { const int i = tid + 512 * k, rr = i >> 6, ch = i & 63, t = t0_ - 30 + rr; st_[k] = (u32x4){0u, 0u, 0u, 0u}; \
            if (i < 62 * 64 && t >= 0) st_[k] = *(const u32x4*)(Z + (rb_ + t) * ZLD + COL_U + ch * 8); } \
        _Pragma("unroll") for (int k = 0; k < 4; ++k) gate_[k] = *(const u32x4*)(Z + (rb_ + t0_ + wid * 4 + k) * ZLD + COL_CG + lane * 8); } while (0)
    u32x4 st[8], gate[4];
    int tile = bid;
    CONV_LOAD(tile, st, gate);
    for (;;) {
        const int bl = tile >> 6, t0 = (tile & 63) * 32; const size_t rowbase = (size_t)bl * SEQ;
#pragma unroll
        for (int k = 0; k < 8; ++k) { const int i = tid + 512 * k, rr = i >> 6, ch = i & 63;
            if (i < 62 * 64) *(LAS u32x4*)(us + rr * 512 + ch * 8) = st[k]; }
        lds_barrier();
        {
            const LAS unsigned* us32 = (const LAS unsigned*)us + (th * 16) * 256 + cp;
            f32x2 uw[46];
#pragma unroll
            for (int i = 0; i < 46; ++i) { const unsigned v = us32[i * 256]; uw[i].x = bflo(v); uw[i].y = bfhi(v); }
#pragma unroll
            for (int tt = 0; tt < 16; ++tt) { f32x2 a = bias;
#pragma unroll
                for (int j = 0; j < 31; ++j) a = __builtin_elementwise_fma(w[j], uw[tt + j], a);
                *(LAS f32x2*)(vs + (th * 16 + tt) * 512 + 2 * cp) = a; }
        }
        lds_barrier();
        const int ntile = tile + G; const bool more = ntile < NT;
        u32x4 gate_n[4];
#pragma unroll
        for (int k = 0; k < 4; ++k) gate_n[k] = (u32x4){0u, 0u, 0u, 0u};
        if (more) CONV_LOAD(ntile, st, gate_n);
        const f32x4 g0 = *(const f32x4*)lg, g1 = *(const f32x4*)(lg + 4), b0 = *(const f32x4*)lb, b1 = *(const f32x4*)(lb + 4);
#pragma unroll
        for (int k = 0; k < 4; ++k) { const int tt = wid * 4 + k;
            f32x4 x0 = *(const LAS f32x4*)(vs + tt * 512 + lane * 8), x1 = *(const LAS f32x4*)(vs + tt * 512 + lane * 8 + 4);
            const float mean = wave_sum((x0.x + x0.y) + (x0.z + x0.w) + (x1.x + x1.y) + (x1.z + x1.w)) * (1.f / 512);
            x0 = x0 - mean; x1 = x1 - mean;
            const float var = wave_sum(x0.x * x0.x + x0.y * x0.y + x0.z * x0.z + x0.w * x0.w + x1.x * x1.x + x1.y * x1.y + x1.z * x1.z + x1.w * x1.w) * (1.f / 512);
            const float rstd = rsqrtf(var + EPS);
            f32x4 y0 = x0 * rstd * g0 + b0, y1 = x1 * rstd * g1 + b1;
            bf16_t* gp = Z + (rowbase + t0 + tt) * ZLD + COL_CG + lane * 8;
            const u32x4 gv = gate[k];
            float o[8];
            o[0] = y0.x * sigmoidf_(y0.x) * bflo(gv.x); o[1] = y0.y * sigmoidf_(y0.y) * bfhi(gv.x); o[2] = y0.z * sigmoidf_(y0.z) * bflo(gv.y); o[3] = y0.w * sigmoidf_(y0.w) * bfhi(gv.y);
            o[4] = y1.x * sigmoidf_(y1.x) * bflo(gv.z); o[5] = y1.y * sigmoidf_(y1.y) * bfhi(gv.z); o[6] = y1.z * sigmoidf_(y1.z) * bflo(gv.w); o[7] = y1.w * sigmoidf_(y1.w) * bfhi(gv.w);
            u32x4 v; v.x = pk2(o[0], o[1]); v.y = pk2(o[2], o[3]); v.z = pk2(o[4], o[5]); v.w = pk2(o[6], o[7]);
            *(u32x4*)gp = v; }
        lds_barrier();
        if (!more) break;
        tile = ntile;
#pragma unroll
        for (int k = 0; k < 4; ++k) gate[k] = gate_n[k];
    }
#undef CONV_LOAD
}
template <int W> __device__ __forceinline__ void pool_window(LAS bf16_t* col, int base, int t0) {
    constexpr int PLD = 520;
    float v[47];
#pragma unroll
    for (int k = 16 - W; k < 47; ++k) v[k] = bf2f(col[(base + k) * PLD]);
    float s = 0.f;
#pragma unroll
    for (int k = 16 - W; k < 15; ++k) s += v[k];
    const float iw = 1.f / W;
#pragma unroll
    for (int j = 0; j < 32; ++j) {
        s += v[j + 15];
        const int t = t0 + base + j;
        const float ic = (t + 1 >= W) ? iw : __builtin_amdgcn_rcpf((float)(t + 1));
        const float pooled = s * ic - v[j + 15];
        s -= v[j + 16 - W];
        col[(base + j) * PLD] = (bf16_t)(pk2(pooled, 0.f) & 0xffffu);
    }
}
__device__ __forceinline__ void pool_tile(CP* pp, int l, bf16_t* Z, const bf16_t* WpoolT, int tile, LAS unsigned char* lds) {
    const int tid = opaque_tid(), wid = __builtin_amdgcn_readfirstlane(tid >> 6), lane = tid & 63, fr = lane & 15, fq = lane >> 4;
    const int bl = tile >> 5, t0 = (tile & 31) * 64; const size_t rowbase = (size_t)bl * SEQ;
    constexpr int PLD = 520;
    LAS bf16_t* pl = (LAS bf16_t*)lds;
    const int g = wid >> 1, ch0 = g * 128 + (wid & 1) * 64;
    bf16x8 bw[4][4];
#pragma unroll
    for (int nt = 0; nt < 4; ++nt)
#pragma unroll
        for (int kk = 0; kk < 4; ++kk) bw[nt][kk] = *(const bf16x8*)(WpoolT + ((size_t)ch0 + nt * 16 + fr) * 128 + kk * 32 + fq * 8);
    u32x2 gv[4][4];
#pragma unroll
    for (int rt = 0; rt < 4; ++rt)
#pragma unroll
        for (int nt = 0; nt < 4; ++nt) gv[rt][nt] = *(const u32x2*)(Z + (rowbase + t0 + rt * 16 + fr) * ZLD + COL_PG + ch0 + nt * 16 + fq * 4);
    {
        u32x4 st[10];
#pragma unroll
        for (int k = 0; k < 10; ++k) { const int i = tid + 512 * k, rr = i >> 6, ch = i & 63, t = t0 - 15 + rr; st[k] = (u32x4){0u, 0u, 0u, 0u};
            if (i < 79 * 64 && t >= 0) st[k] = *(const u32x4*)(Z + (rowbase + t) * ZLD + COL_P + ch * 8); }
#pragma unroll
        for (int k = 0; k < 10; ++k) { const int i = tid + 512 * k, rr = i >> 6, ch = i & 63;
            if (i < 79 * 64) *(LAS u32x4*)(pl + rr * PLD + ch * 8) = st[k]; }
    }
    lds_barrier();
    {
        LAS bf16_t* col = pl + tid;
        const int gg = wid >> 1;
        if (gg == 0) { pool_window<2>(col, 0, t0); pool_window<2>(col, 32, t0); }
        else if (gg == 1) { pool_window<4>(col, 0, t0); pool_window<4>(col, 32, t0); }
        else if (gg == 2) { pool_window<8>(col, 0, t0); pool_window<8>(col, 32, t0); }
        else { pool_window<16>(col, 0, t0); pool_window<16>(col, 32, t0); }
    }
    lds_barrier();
    {
        const float* pb = pp->in[12] + l * 512 + ch0 + fq * 4; const float* sc = pp->in[13] + l * 512 + ch0 + fq * 4;
        f32x4 bb[4], ss[4];
#pragma unroll
        for (int nt = 0; nt < 4; ++nt) { bb[nt] = *(const f32x4*)(pb + nt * 16); ss[nt] = *(const f32x4*)(sc + nt * 16); }
#pragma unroll
        for (int rt = 0; rt < 4; ++rt) {
            bf16x8 a[4];
#pragma unroll
            for (int kk = 0; kk < 4; ++kk) a[kk] = *(const LAS bf16x8*)(pl + (rt * 16 + fr) * PLD + g * 128 + kk * 32 + fq * 8);
#pragma unroll
            for (int nt = 0; nt < 4; ++nt) { f32x4 acc = (f32x4){0.f, 0.f, 0.f, 0.f};
#pragma unroll
                for (int kk = 0; kk < 4; ++kk) acc = __builtin_amdgcn_mfma_f32_16x16x32_bf16(bw[nt][kk], a[kk], acc, 0, 0, 0);
                const u32x2 q = gv[rt][nt];
                u32x2 v; v.x = pk2((acc[0] + bb[nt].x) * ss[nt].x * bflo(q.x), (acc[1] + bb[nt].y) * ss[nt].y * bfhi(q.x)); v.y = pk2((acc[2] + bb[nt].z) * ss[nt].z * bflo(q.y), (acc[3] + bb[nt].w) * ss[nt].w * bfhi(q.y));
                *(u32x2*)(Z + (rowbase + t0 + rt * 16 + fr) * ZLD + COL_PG + ch0 + nt * 16 + fq * 4) = v; }
        }
    }
    lds_barrier();
}
__device__ __forceinline__ float xhalf_max(float v) { const auto rr = __builtin_amdgcn_permlane32_swap(__float_as_uint(v), __float_as_uint(v), false, false); return fmaxf(__uint_as_float(rr[0]), __uint_as_float(rr[1])); }
__device__ __forceinline__ float xhalf_sum(float v) { const auto rr = __builtin_amdgcn_permlane32_swap(__float_as_uint(v), __float_as_uint(v), false, false); return __uint_as_float(rr[0]) + __uint_as_float(rr[1]); }
typedef short v4i16_t __attribute__((ext_vector_type(4)));
__device__ __forceinline__ v4i16_t tr_read(const LAS unsigned char* p) { return __builtin_amdgcn_ds_read_tr16_b64_v4i16((LAS v4i16_t*)p); }
constexpr int ATT_KS = 144, ATT_KB = 32 * ATT_KS, ATT_VH = 2112, ATT_TAB = 9216, ATT_WAVE = ATT_TAB + 2304;
__device__ __forceinline__ void attn_wave(CP* pp, int l, bf16_t* Z, int bl, int h, int c, int lane, LAS unsigned char* wl) {
    const int r = lane & 31, hh = lane >> 5;
    const size_t rowbase = (size_t)bl * SEQ;
    const int q0 = c * 64;
    const bf16_t* HMb = (const bf16_t*)(pp->ws + WS_HM); const size_t hrow = (size_t)(bl * 8 + h) * SEQ;
    bf16x8 qf[2][4];
#pragma unroll
    for (int qt = 0; qt < 2; ++qt)
#pragma unroll
        for (int s = 0; s < 4; ++s) qf[qt][s] = *(const bf16x8*)(HMb + (hrow + q0 + qt * 32 + r) * 64 + 16 * s + 8 * hh);
    const float* tabg = pp->in[9] + ((size_t)l * 8 + h) * 513;
    constexpr float LOG2E = 1.4426950408889634f;
    const float c512 = tabg[512] * LOG2E;
    LAS float* tab = (LAS float*)(wl + ATT_TAB);
#pragma unroll
    for (int i = 0; i < 5; ++i) tab[192 + 64 * i + lane] = tabg[192 + 64 * i + lane] * LOG2E;
    if (lane == 0) tab[512] = c512;
    float m_run[2] = {-1e30f, -1e30f}, l_run[2] = {0.f, 0.f};
    f32x16 o[2][2];
#pragma unroll
    for (int a = 0; a < 2; ++a)
#pragma unroll
        for (int b = 0; b < 2; ++b)
#pragma unroll
            for (int i = 0; i < 16; ++i) o[a][b][i] = 0.f;
    const int kstart = max(0, q0 - 512), kend = q0 + 64;
    const int skey = lane >> 3, sch = lane & 7;
    const bf16_t* kg = HMb + HMSEG + (hrow + skey) * 64 + sch * 8;
    const bf16_t* vg = HMb + 2 * HMSEG + (hrow + skey) * 64 + sch * 8;
    LAS unsigned char* kw = wl + skey * ATT_KS + sch * 16;
    LAS unsigned char* vw = wl + ATT_KB + (sch >> 2) * ATT_VH + skey * 64 + (sch & 3) * 16;
    const LAS unsigned char* kr = wl + r * ATT_KS + 16 * hh;
    const LAS unsigned char* vr = wl + ATT_KB + (4 * hh + ((lane & 15) >> 2)) * 64 + (16 * ((lane >> 4) & 1) + 4 * (lane & 3)) * 2;
    u32x4 pk_[4], pv_[4];
#pragma unroll
    for (int i = 0; i < 4; ++i) { pk_[i] = *(const u32x4*)(kg + (size_t)(kstart + 8 * i) * 64); pv_[i] = *(const u32x4*)(vg + (size_t)(kstart + 8 * i) * 64); }
#pragma unroll
    for (int i = 0; i < 4; ++i) { *(LAS u32x4*)(kw + i * 8 * ATT_KS) = pk_[i]; *(LAS u32x4*)(vw + i * 512) = pv_[i]; }
    for (int kt = kstart; kt < kend; kt += 32) {
        const bool more = kt + 32 < kend;
        if (more) {
#pragma unroll
            for (int i = 0; i < 4; ++i) { pk_[i] = *(const u32x4*)(kg + (size_t)(kt + 32 + 8 * i) * 64); pv_[i] = *(const u32x4*)(vg + (size_t)(kt + 32 + 8 * i) * 64); }
        }
        bf16x8 kf[4];
#pragma unroll
        for (int s4 = 0; s4 < 4; ++s4) kf[s4] = *(const LAS bf16x8*)(kr + 32 * s4);
        bf16x8 pb[2][2];
#pragma unroll
        for (int qt = 0; qt < 2; ++qt) {
            f32x16 s;
            const int dqk = q0 + qt * 32 - kt;
            if (dqk > 256) {
#pragma unroll
                for (int i = 0; i < 16; ++i) s[i] = c512;
            } else if (dqk == 256) {
                const int rel0 = dqk + r - 4 * hh;
#pragma unroll
                for (int i = 0; i < 16; ++i) { const int rel = rel0 - ((i & 3) + 8 * (i >> 2)); s[i] = tab[min(rel, 256) + 256]; }
            } else {
                const LAS float* tb = tab + (dqk + r - 4 * hh + 256 - 27);
#pragma unroll
                for (int i = 0; i < 16; ++i) s[i] = tb[27 - ((i & 3) + 8 * (i >> 2))];
            }
#pragma unroll
            for (int s4 = 0; s4 < 4; ++s4) s = __builtin_amdgcn_mfma_f32_32x32x16_bf16(kf[s4], qf[qt][s4], s, 0, 0, 0);
            float mx = s[0];
#pragma unroll
            for (int i = 1; i < 16; ++i) mx = fmaxf(mx, s[i]);
            mx = xhalf_max(mx);
            float m_new = m_run[qt];
            if (__builtin_amdgcn_ballot_w64(mx > m_run[qt] + 6.f) != 0ull) {
                m_new = fmaxf(m_run[qt], mx);
                const float alpha = __builtin_amdgcn_exp2f(m_run[qt] - m_new);
                l_run[qt] *= alpha; m_run[qt] = m_new;
#pragma unroll
                for (int i = 0; i < 16; ++i) { o[qt][0][i] *= alpha; o[qt][1][i] *= alpha; }
            }
            float pv[16];
#pragma unroll
            for (int i = 0; i < 16; ++i) pv[i] = __builtin_amdgcn_exp2f(s[i] - m_new);
            float ps = ((pv[0] + pv[1]) + (pv[2] + pv[3])) + ((pv[4] + pv[5]) + (pv[6] + pv[7])) + (((pv[8] + pv[9]) + (pv[10] + pv[11])) + ((pv[12] + pv[13]) + (pv[14] + pv[15])));
            ps = xhalf_sum(ps);
            l_run[qt] += ps;
#pragma unroll
            for (int s2 = 0; s2 < 2; ++s2) { u32x4 t; t.x = pk2(pv[8 * s2 + 0], pv[8 * s2 + 1]); t.y = pk2(pv[8 * s2 + 2], pv[8 * s2 + 3]); t.z = pk2(pv[8 * s2 + 4], pv[8 * s2 + 5]); t.w = pk2(pv[8 * s2 + 6], pv[8 * s2 + 7]);
                pb[qt][s2] = __builtin_bit_cast(bf16x8, t); }
        }
#pragma unroll
        for (int dt = 0; dt < 2; ++dt)
#pragma unroll
            for (int s2 = 0; s2 < 2; ++s2) {
                const v4i16_t lo = tr_read(vr + dt * ATT_VH + s2 * 1024), hi = tr_read(vr + dt * ATT_VH + s2 * 1024 + 512);
                const bf16x8 vf = __builtin_shufflevector(lo, hi, 0, 1, 2, 3, 4, 5, 6, 7);
                o[0][dt] = __builtin_amdgcn_mfma_f32_32x32x16_bf16(vf, pb[0][s2], o[0][dt], 0, 0, 0);
                o[1][dt] = __builtin_amdgcn_mfma_f32_32x32x16_bf16(vf, pb[1][s2], o[1][dt], 0, 0, 0);
            }
        if (more) {
#pragma unroll
            for (int i = 0; i < 4; ++i) { *(LAS u32x4*)(kw + i * 8 * ATT_KS) = pk_[i]; *(LAS u32x4*)(vw + i * 512) = pv_[i]; }
        }
    }
#pragma unroll
    for (int qt = 0; qt < 2; ++qt) {
        const float inv = __builtin_amdgcn_rcpf(l_run[qt]);
        bf16_t* gp = Z + (rowbase + q0 + qt * 32 + r) * ZLD + COL_AG + h * 64 + 4 * hh;
#pragma unroll
        for (int dt = 0; dt < 2; ++dt)
#pragma unroll
            for (int g4 = 0; g4 < 4; ++g4) { bf16_t* a = gp + dt * 32 + 8 * g4; const u32x2 gv = *(const u32x2*)(HMb + 3 * HMSEG + (hrow + q0 + qt * 32 + r) * 64 + 4 * hh + dt * 32 + 8 * g4);
                u32x2 v; v.x = pk2(o[qt][dt][4 * g4 + 0] * inv * bflo(gv.x), o[qt][dt][4 * g4 + 1] * inv * bfhi(gv.x)); v.y = pk2(o[qt][dt][4 * g4 + 2] * inv * bflo(gv.y), o[qt][dt][4 * g4 + 3] * inv * bfhi(gv.y));
                *(u32x2*)a = v; }
    }
}
__device__ __forceinline__ void phase2(CP* pp, int l, LAS unsigned char* lds, int parts = 7) {
    const int G = gridDim.x, bid = blockIdx.x, tid = opaque_tid(), wid = tid >> 6, lane = tid & 63;
    bf16_t* Z = (bf16_t*)(pp->ws + WS_Z);
    const bf16_t* WpoolT = (const bf16_t*)(pp->ws + WS_WPOOL) + (size_t)l * 4 * 128 * 128;
    if (parts & 1) {
        const int uw = __builtin_amdgcn_readfirstlane(wid);
        int round = 0;
        for (int it = bid; it < NBC * 8 * 4; it += G, ++round) {
            const int pair = it >> 2, q = ((it & 3) + round) & 3, bl = pair >> 3, h = pair & 7;
            const int sd = uw & 3, hf = uw >> 2;
            const int c = (sd == q) ? (hf ? 7 - q : q) : (8 + 6 * q + 2 * (sd < q ? sd : sd - 1) + hf);
            attn_wave(pp, l, Z, bl, h, c, lane, lds + uw * ATT_WAVE);
        }
        __syncthreads();
    }
    if (parts & 2) { conv_phase(pp, l, Z, lds); __syncthreads(); }
    if (parts & 4) { for (int t = bid; t < MC / 64; t += G) pool_tile(pp, l, Z, WpoolT, t, lds); __syncthreads(); }
}

__device__ __forceinline__ void phase5(CP* pp, int l, int chunk) {
    const int G = gridDim.x, bid = blockIdx.x, tid = opaque_tid(), wid = tid >> 6, lane = tid & 63;
    const bf16_t* Y = (const bf16_t*)(pp->ws + WS_Y); const float* part = (const float*)(pp->ws + WS_PART);
    bf16_t* xb = (bf16_t*)(pp->ws + WS_XB); float* rinv = (float*)(pp->ws + WS_RINV);
    const bool first = (l == 0), last = (l == DEPTH - 1);
    const f32x4* gp = (const f32x4*)(pp->in[2] + l * D) + lane;
    f32x4 g[4];
#pragma unroll
    for (int j = 0; j < 4; ++j) g[j] = gp[64 * j];
    for (int lr = bid * 8 + wid; lr < MC; lr += G * 8) {
        const size_t row = (size_t)chunk * MC + lr;
        float ss = (lane < 16) ? part[(size_t)lr * 16 + lane] : 0.f;
        const u32x2* yr = (const u32x2*)(Y + (size_t)lr * D) + lane; u32x2* xo = (u32x2*)(xb + row * D) + lane;
        f32x4 xv[4]; u32x2 yv[4];
        if (first) { const f32x4* xr = (const f32x4*)(pp->in[0] + row * D) + lane;
#pragma unroll
            for (int j = 0; j < 4; ++j) xv[j] = xr[64 * j];
        } else {
#pragma unroll
            for (int j = 0; j < 4; ++j) { const u32x2 v = xo[64 * j]; xv[j].x = bflo(v.x); xv[j].y = bfhi(v.x); xv[j].z = bflo(v.y); xv[j].w = bfhi(v.y); }
        }
#pragma unroll
        for (int j = 0; j < 4; ++j) yv[j] = yr[64 * j];
        ss = wave_sum(ss);
        const float ry = rsqrtf(ss * (1.f / D) + EPS);
        float s2 = 0.f;
#pragma unroll
        for (int j = 0; j < 4; ++j) { f32x4 o;
            o.x = xv[j].x + bflo(yv[j].x) * ry * g[j].x; o.y = xv[j].y + bfhi(yv[j].x) * ry * g[j].y; o.z = xv[j].z + bflo(yv[j].y) * ry * g[j].z; o.w = xv[j].w + bfhi(yv[j].y) * ry * g[j].w;
            if (last) { ((f32x4*)(pp->out + row * D) + lane)[64 * j] = o; }
            else { s2 += o.x * o.x + o.y * o.y + o.z * o.z + o.w * o.w; u32x2 w; w.x = pk2(o.x, o.y); w.y = pk2(o.z, o.w); xo[64 * j] = w; } }
        if (!last) { s2 = wave_sum(s2); if (lane == 0) rinv[row] = rsqrtf(s2 * (1.f / D) + EPS); }
    }
}

#ifndef GEMM_ALIGN
#define GEMM_ALIGN true
#endif
#ifndef GEMM_SP2
#define GEMM_SP2 true
#endif
#ifndef PROBE
#define PROBE 0
#endif
constexpr int R12 = (PROBE >= 1 && PROBE <= 4) ? 2 : 1, PROBE_PARTS = PROBE == 2 ? 1 : (PROBE == 3 ? 2 : (PROBE == 4 ? 4 : 0)), R3 = PROBE == 5 ? 2 : 1, R4 = PROBE == 6 ? 2 : 1, RSYNC = PROBE == 7 ? 8 : 0;
__global__ void __launch_bounds__(512, 2) mega(Params p_unused) {
    extern __shared__ __attribute__((aligned(16))) unsigned char smem[];
    LAS unsigned char* lds = (LAS unsigned char*)smem;
    const int mode = opaque_params()->mode;
    int ph = 0;
    if (mode == -2) cg::this_grid().sync();
    XcdBarrier xb;
    { volatile LAS unsigned* st = (volatile LAS unsigned*)(lds + LDS_STAGE);
      if (threadIdx.x == 0) { st[0] = 0u; st[1] = 0u; }
      __syncthreads();
      xb = xcd_barrier_post((unsigned*)(opaque_params()->ws + WS_BAR), st);
      if (mode >= 0) xb.x = 0; }
#define SEAM() do { if (mode < 0) { xcd_barrier(xb); } ++ph; } while (0)
#define RUN(ph_) (mode < 0 || mode == (ph_))
#ifndef SKIP_P0
    if (RUN(ph)) phase0(opaque_params(), lds);
#endif
    SEAM();
#define DO_P1(l_, ch_) do { CP* pp = opaque_params(); unsigned char* ws = pp->ws; const int G = gridDim.x, bid = blockIdx.x; \
        pg8::Gemm g{(const bf16_t*)(ws + WS_XB) + (size_t)(ch_) * MC * D, (const bf16_t*)(ws + WS_WIN) + (size_t)(l_) * NIN * D, D, D}; \
        pg8::PlainSched S; S.init(MC, NIN1, D, D, G, bid); \
        pg8::Epi1 E{(bf16_t*)(ws + WS_Z), (const float*)(ws + WS_RINV) + (size_t)(ch_) * MC, (bf16_t*)(ws + WS_HM)}; \
        pg8::gemm_phase<GEMM_ALIGN, GEMM_SP2>(lds, g, S, E); } while (0)
    constexpr int NP = DEPTH * NCH;
    int p1_l = 0, p1_ch = 0;
    bool p1_first = true;
    for (int k = 0; k <= NP; ++k) {
        const int l = k / NCH, ch = k - l * NCH;
        if (RUN(ph)) {
            if (k > 0) phase5(opaque_params(), (k - 1) / NCH, (k - 1) % NCH);
            if (NCH > 1 && k < NP) DO_P1(l, ch);
        }
        if (k == NP || (k == 0 && NCH == 1)) ++ph; else SEAM();
        if (k == NP) break;
        if (NCH == 1) { if (RUN(ph)) DO_P1(l, ch); SEAM(); }
        for (int rep = 1; rep < R12; ++rep) {
            if (RUN(ph)) phase2(opaque_params(), l, lds, PROBE_PARTS);
            SEAM();
            if (RUN(ph)) DO_P1(l, ch);
            SEAM();
        }
        if (RUN(ph)) phase2(opaque_params(), l, lds, 7);
        SEAM();
        for (int rep = 0; rep < R3; ++rep) {
            if (RUN(ph)) {
                CP* pp = opaque_params(); unsigned char* ws = pp->ws; const int G = gridDim.x, bid = blockIdx.x;
                pg8::Gemm2 g{(const bf16_t*)(ws + WS_Z), (const bf16_t*)(ws + WS_XB) + (size_t)ch * MC * D, (const bf16_t*)(ws + WS_WGY) + (size_t)l * 9216 * 512, ZLD, D, 512};
                pg8::BranchSched2 S; S.init(MC, G, bid);
                pg8::EpiGY E{(bf16_t*)(ws + WS_GS) + (size_t)bid * 65536, (const float*)(ws + WS_RINV) + (size_t)ch * MC, (bf16_t*)(ws + WS_MG)};
                pg8::gemm_phase_mix(lds, g, S, E);
            }
            SEAM();
        }
        for (int rep = 0; rep < R4; ++rep) {
            if (RUN(ph)) {
                CP* pp = opaque_params(); unsigned char* ws = pp->ws; const int G = gridDim.x, bid = blockIdx.x;
                pg8::Gemm g{(const bf16_t*)(ws + WS_MG), (const bf16_t*)(ws + WS_WOUT) + (size_t)l * D * D, D, D};
                pg8::PlainSched S; S.init(MC, D, D, D, G, bid);
                pg8::Epi4 E{(bf16_t*)(ws + WS_Y), (float*)(ws + WS_PART)};
                pg8::gemm_phase<GEMM_ALIGN, GEMM_SP2>(lds, g, S, E);
            }
            SEAM();
        }
        for (int rep = 0; rep < RSYNC; ++rep) SEAM();
    }
    (void)p1_l; (void)p1_ch; (void)p1_first;
#undef DO_P1
#undef SEAM
#undef RUN
}
constexpr int N_PHASES = 1 + (DEPTH * NCH + 1) + DEPTH * NCH * (2 * (R12 - 1) + 1 + R3 + R4 + RSYNC);

extern "C" void kernel_launch(void* const* d_in, const int* in_sizes, int n_in, void* d_out, int out_size, void* d_ws, size_t ws_size, hipStream_t stream) {
    static int grid = 0;
    if (grid == 0) {
        if (n_in != 16 || in_sizes[0] != NTOK * D || out_size != NTOK * D || ws_size < WS_END) {
            fprintf(stderr, "kernel_launch: unexpected shapes (n_in %d, in0 %d, out %d, ws %zu < %zu)\n", n_in, n_in > 0 ? in_sizes[0] : -1, out_size, ws_size, (size_t)WS_END); grid = -1; return; }
        int dev = 0, cus = 0, per_cu = 0;
        (void)hipGetDevice(&dev); (void)hipDeviceGetAttribute(&cus, hipDeviceAttributeMultiprocessorCount, dev);
        if (hipFuncSetAttribute((const void*)mega, hipFuncAttributeMaxDynamicSharedMemorySize, LDS_BYTES) != hipSuccess) { fprintf(stderr, "kernel_launch: hipFuncSetAttribute failed\n"); grid = -1; return; }
        if (hipOccupancyMaxActiveBlocksPerMultiprocessor(&per_cu, (const void*)mega, 512, LDS_BYTES) != hipSuccess || per_cu < 1) { fprintf(stderr, "kernel_launch: occupancy query says %d\n", per_cu); per_cu = 1; }
        (void)hipGetLastError();
        grid = cus * per_cu; if (grid > MAXG) grid = MAXG;
        fprintf(stderr, "kernel_launch: grid %d (%d CUs x %d)\n", grid, cus, per_cu);
    }
    if (grid < 0) return;
    Params p{};
    for (int i = 0; i < 16; ++i) p.in[i] = (const float*)d_in[i];
    p.out = (float*)d_out; p.ws = (unsigned char*)d_ws; p.pad = 0;
#if ONE_LAUNCH
    p.mode = -1;
    if (hipMemsetAsync((char*)d_ws + WS_BAR, 0, WS_BAR_BYTES, stream) != hipSuccess) { fprintf(stderr, "kernel_launch: memset of the barrier words failed\n"); return; }
    void* args[] = {&p};
    hipError_t e = hipLaunchCooperativeKernel((const void*)mega, dim3(grid), dim3(512), args, LDS_BYTES, stream);
    if (e != hipSuccess) fprintf(stderr, "cooperative launch failed: %s (grid %d)\n", hipGetErrorString(e), grid);
#else
    for (int ph = 0; ph < N_PHASES; ++ph) { p.mode = ph; hipLaunchKernelGGL(mega, dim3(grid), dim3(512), LDS_BYTES, stream, p); }
#endif
}
```
